# Optimizing an MI355X kernel written in HIP

```python
import math
import jax, jax.numpy as jnp
from jax import lax
import numpy as np

D_MODEL = 4096
BATCH = 2
SEQ = 8192
DEPTH = 1

HYENA_WIDTH = D_MODEL // 2
DIFF_WIDTH = D_MODEL - HYENA_WIDTH
DIFF_HEAD_DIM = 128
DIFF_HEADS = DIFF_WIDTH // (2 * DIFF_HEAD_DIM)
DIFF_QK_WIDTH = DIFF_HEADS * 2 * DIFF_HEAD_DIM
IN_WIDTH = 3 * HYENA_WIDTH + 2 * DIFF_QK_WIDTH + DIFF_WIDTH
SHORT_CONV = 3
FILTER_EMB_DIM = 33
FILTER_BANDS = (FILTER_EMB_DIM - 1) // 2
FILTER_HIDDEN = 64
FAST_DECAY_PCT = 0.3
SLOW_DECAY_PCT = 1.5
DECAY_TARGET = 1e-2
FFN_HIDDEN = ((-(-8 * D_MODEL // 3)) + 255) // 256 * 256
ROPE_THETA = 10000.0
NORM_EPS = 1e-6
SUBLN_EPS = 1e-5
Q_BLOCK = 128
N_MOD = 6

kernel_name = "hymba_hyena_diffattn_adaln_block"


def rmsnorm(x, g, eps):
    xf = x.astype(jnp.float32)
    y = xf * lax.rsqrt(jnp.mean(xf * xf, axis=-1, keepdims=True) + eps)
    return (y * g.astype(jnp.float32)).astype(x.dtype)


def short_conv(u, w, b):
    L = u.shape[1]
    pad = SHORT_CONV // 2
    up = jnp.pad(u, ((0, 0), (pad, SHORT_CONV - 1 - pad), (0, 0)))
    out = b
    for j in range(SHORT_CONV):
        out = out + up[:, j:j + L] * w[j]
    return out


def hyena_pos_features(L):
    t = jnp.linspace(0.0, 1.0, L, dtype=jnp.float32)[:, None]
    t_idx = jnp.arange(L, dtype=jnp.float32)[:, None]
    w = 2.0 * math.pi * t_idx / L
    f = jnp.linspace(1e-4, FILTER_BANDS - 1, FILTER_BANDS, dtype=jnp.float32)[None, :]
    z = jnp.concatenate([t, jnp.cos(f * w), -jnp.sin(f * w)], axis=-1)
    return z, t


def hyena_filters(z, t, f_w1, f_b1, f_w2, f_b2, f_w3, f_b3, f_w4, f_freq):
    act = lambda h: jnp.sin(f_freq * h)
    h = act(z @ f_w1 + f_b1)
    h = act(h @ f_w2 + f_b2)
    h = act(h @ f_w3 + f_b3)
    h = (h @ f_w4).astype(jnp.float32)
    L = z.shape[0]
    min_decay = math.log(DECAY_TARGET) / SLOW_DECAY_PCT
    max_decay = math.log(DECAY_TARGET) / FAST_DECAY_PCT
    deltas = jnp.linspace(min_decay, max_decay, HYENA_WIDTH, dtype=jnp.float32)
    decay = jnp.exp(-t * jnp.abs(deltas))
    h = h.reshape(L, 2, HYENA_WIDTH) * decay[:, None, :]
    return h[:, 0], h[:, 1]


def two_sided_kernel(h_f, h_b):
    zero = jnp.zeros((1, h_f.shape[1]), h_f.dtype)
    return jnp.concatenate([h_f, zero, h_b[:0:-1]], axis=0)


def fft_long_conv(u, kern):
    L = u.shape[1]
    n = 2 * L
    U = jnp.fft.rfft(u.astype(jnp.float32), n=n, axis=1)
    K = jnp.fft.rfft(kern.astype(jnp.float32), n=n, axis=0)
    return jnp.fft.irfft(U * K[None], n=n, axis=1)[:, :L]


def hyena_mixer(u, conv_w, conv_b, z, t, f_w1, f_b1, f_w2, f_b2, f_w3, f_b3, f_w4,
                f_freq, hyena_bias):
    u = short_conv(u, conv_w, conv_b)
    x0, x1, v = jnp.split(u, 3, axis=-1)
    h_f, h_b = hyena_filters(z, t, f_w1, f_b1, f_w2, f_b2, f_w3, f_b3, f_w4, f_freq)
    kern = two_sided_kernel(h_f, h_b)
    v = v * x1
    y = fft_long_conv(v, kern).astype(v.dtype) + v * hyena_bias
    return y * x0


def rope_cos_sin(positions, dim):
    inv = 1.0 / (ROPE_THETA ** (jnp.arange(0, dim, 2, dtype=jnp.float32) / dim))
    ang = positions.astype(jnp.float32)[..., None] * inv
    ang = jnp.concatenate([ang, ang], axis=-1)
    return jnp.cos(ang), jnp.sin(ang)


def apply_rope(x, cos, sin):
    c = cos[:, :, None, None, :]
    s = sin[:, :, None, None, :]
    xf = x.astype(jnp.float32)
    x1, x2 = jnp.split(xf, 2, axis=-1)
    rot = jnp.concatenate([-x2, x1], axis=-1)
    return (xf * c + rot * s).astype(x.dtype)


def diff_attention(q, k, v, cos, sin, lambda_q1, lambda_k1, lambda_q2, lambda_k2,
                   subln_g, lam_init):
    B, S, _ = q.shape
    q = apply_rope(q.reshape(B, S, DIFF_HEADS, 2, DIFF_HEAD_DIM), cos, sin)
    k = apply_rope(k.reshape(B, S, DIFF_HEADS, 2, DIFF_HEAD_DIM), cos, sin)
    v = v.reshape(B, S, DIFF_HEADS, 2 * DIFF_HEAD_DIM)
    lam = (jnp.exp(jnp.sum(lambda_q1.astype(jnp.float32) * lambda_k1.astype(jnp.float32)))
           - jnp.exp(jnp.sum(lambda_q2.astype(jnp.float32) * lambda_k2.astype(jnp.float32)))
           + lam_init)
    scale = DIFF_HEAD_DIM ** -0.5
    nb = S // Q_BLOCK
    qb = q.reshape(B, nb, Q_BLOCK, DIFF_HEADS, 2, DIFF_HEAD_DIM).transpose(1, 0, 2, 3, 4, 5)

    def block(q_blk):
        s = jnp.einsum('bqhjd,bkhjd->bhjqk', q_blk, k).astype(jnp.float32) * scale
        p = jax.nn.softmax(s, axis=-1)
        a = p[:, :, 0] - lam * p[:, :, 1]
        return jnp.einsum('bhqk,bkhe->bqhe', a.astype(v.dtype), v)

    o = lax.map(block, qb)
    o = o.transpose(1, 0, 2, 3, 4).reshape(B, S, DIFF_HEADS, 2 * DIFF_HEAD_DIM)
    o = rmsnorm(o, subln_g, SUBLN_EPS) * (1.0 - lam_init)
    return o.reshape(B, S, DIFF_WIDTH)


def setup_inputs(seed: int = 0) -> dict:
    key = jax.random.key(seed)
    ks = jax.random.split(key, 32)
    f32 = jnp.float32
    nrm = lambda k, shape, s: jax.random.normal(k, shape, f32) * s
    C = HYENA_WIDTH
    return {
        "x": nrm(ks[0], (BATCH, SEQ, D_MODEL), 1.0),
        "c": nrm(ks[1], (BATCH, D_MODEL), 1.0),
        "positions": (jnp.arange(SEQ, dtype=jnp.int32)[None, :]
                      + jax.random.randint(ks[2], (BATCH, 1), 0, 1024, dtype=jnp.int32)),
        "w_ada": nrm(ks[3], (DEPTH, D_MODEL, N_MOD * D_MODEL), 0.5 * D_MODEL ** -0.5),
        "b_ada": nrm(ks[4], (DEPTH, N_MOD * D_MODEL), 0.1),
        "g_mix": 1.0 + nrm(ks[5], (DEPTH, D_MODEL), 0.02),
        "g_ffn": 1.0 + nrm(ks[6], (DEPTH, D_MODEL), 0.02),
        "w_in": nrm(ks[7], (DEPTH, D_MODEL, IN_WIDTH), D_MODEL ** -0.5),
        "conv_w": nrm(ks[8], (DEPTH, SHORT_CONV, 3 * C), SHORT_CONV ** -0.5),
        "conv_b": nrm(ks[9], (DEPTH, 3 * C), 0.02),
        "f_w1": nrm(ks[10], (DEPTH, FILTER_EMB_DIM, FILTER_HIDDEN), FILTER_EMB_DIM ** -0.5),
        "f_b1": nrm(ks[11], (DEPTH, FILTER_HIDDEN), 0.1),
        "f_w2": nrm(ks[12], (DEPTH, FILTER_HIDDEN, FILTER_HIDDEN), FILTER_HIDDEN ** -0.5),
        "f_b2": nrm(ks[13], (DEPTH, FILTER_HIDDEN), 0.1),
        "f_w3": nrm(ks[14], (DEPTH, FILTER_HIDDEN, FILTER_HIDDEN), FILTER_HIDDEN ** -0.5),
        "f_b3": nrm(ks[15], (DEPTH, FILTER_HIDDEN), 0.1),
        "f_w4": nrm(ks[16], (DEPTH, FILTER_HIDDEN, 2 * C), 0.02 * FILTER_HIDDEN ** -0.5),
        "f_freq": 1.0 + nrm(ks[17], (DEPTH, FILTER_HIDDEN), 0.1),
        "hyena_bias": nrm(ks[18], (DEPTH, C), 1.0),
        "lambda_q1": nrm(ks[19], (DEPTH, DIFF_HEAD_DIM), 0.1),
        "lambda_k1": nrm(ks[20], (DEPTH, DIFF_HEAD_DIM), 0.1),
        "lambda_q2": nrm(ks[21], (DEPTH, DIFF_HEAD_DIM), 0.1),
        "lambda_k2": nrm(ks[22], (DEPTH, DIFF_HEAD_DIM), 0.1),
        "subln_g": 1.0 + nrm(ks[23], (DEPTH, 2 * DIFF_HEAD_DIM), 0.02),
        "w_out": nrm(ks[24], (DEPTH, D_MODEL, D_MODEL), D_MODEL ** -0.5),
        "w_gate": nrm(ks[25], (DEPTH, D_MODEL, FFN_HIDDEN), D_MODEL ** -0.5),
        "w_up": nrm(ks[26], (DEPTH, D_MODEL, FFN_HIDDEN), D_MODEL ** -0.5),
        "w_down": nrm(ks[27], (DEPTH, FFN_HIDDEN, D_MODEL), FFN_HIDDEN ** -0.5),
        "g_final": 1.0 + nrm(ks[28], (D_MODEL,), 0.02),
    }


def reference(x, c, positions, w_ada, b_ada, g_mix, g_ffn, w_in, conv_w, conv_b,
              f_w1, f_b1, f_w2, f_b2, f_w3, f_b3, f_w4, f_freq, hyena_bias,
              lambda_q1, lambda_k1, lambda_q2, lambda_k2, subln_g, w_out,
              w_gate, w_up, w_down, g_final):
    B, L, D = x.shape
    z, t = hyena_pos_features(L)
    cos, sin = rope_cos_sin(positions, DIFF_HEAD_DIM)
    c_act = jax.nn.silu(c)
    split_at = [3 * HYENA_WIDTH, 3 * HYENA_WIDTH + DIFF_QK_WIDTH,
                3 * HYENA_WIDTH + 2 * DIFF_QK_WIDTH]
    for l in range(DEPTH):
        lam_init = 0.8 - 0.6 * math.exp(-0.3 * l)
        mod = c_act @ w_ada[l] + b_ada[l]
        sh1, sc1, gt1, sh2, sc2, gt2 = jnp.split(mod[:, None, :], N_MOD, axis=-1)
        h = rmsnorm(x, g_mix[l], NORM_EPS) * (1.0 + sc1) + sh1
        proj = h @ w_in[l]
        u_hy, q, k, v = jnp.split(proj, split_at, axis=-1)
        y_hy = hyena_mixer(u_hy, conv_w[l], conv_b[l], z, t, f_w1[l], f_b1[l], f_w2[l],
                           f_b2[l], f_w3[l], f_b3[l], f_w4[l], f_freq[l], hyena_bias[l])
        y_da = diff_attention(q, k, v, cos, sin, lambda_q1[l], lambda_k1[l], lambda_q2[l],
                              lambda_k2[l], subln_g[l], lam_init)
        y = jnp.concatenate([y_hy, y_da], axis=-1) @ w_out[l]
        x = x + gt1 * y
        h = rmsnorm(x, g_ffn[l], NORM_EPS) * (1.0 + sc2) + sh2
        f = (jax.nn.silu(h @ w_gate[l]) * (h @ w_up[l])) @ w_down[l]
        x = x + gt2 * f
    return rmsnorm(x, g_final, NORM_EPS)
```

```cpp
#include <hip/hip_runtime.h>
#include <hip/hip_bf16.h>
#include <cstdio>
#include <cstdint>
#ifndef MK_N_LAUNCHES
#define MK_N_LAUNCHES 1
#endif
namespace pg8 {
#define PG8_LAS __attribute__((address_space(3)))
typedef unsigned short bf16_t;
typedef short bf16x8 __attribute__((ext_vector_type(8)));
typedef float f32x4 __attribute__((ext_vector_type(4)));
typedef unsigned u32x4 __attribute__((ext_vector_type(4)));
constexpr int BM = 256, BK = 64, HALF = 128, HTB = HALF * BK * 2  , STAGE_BYTES = 8 * HTB, NXCD = 8, WGM = 4;

__host__ __device__ __forceinline__ int lds_byte(int r, int c) { const int st = (r >> 4) * 2 + (c >> 5), rr = r & 15, cc = c & 31, ob = rr * 64 + cc * 2; return st * 1024 + (ob ^ (((ob >> 9) & 1) << 5)); }
__host__ __device__ __forceinline__ void stage_rc(int b, int& R, int& C) { const int st = b / 1024, sb = b % 1024, swz = sb ^ (((sb >> 9) & 1) << 5); R = (st >> 1) * 16 + swz / 64; C = (st & 1) * 32 + (swz % 64) / 2; }
__host__ __device__ __forceinline__ int perm32(int rho) { const int n = rho >> 4, i = rho & 15; return 8 * (i >> 2) + 4 * n + (i & 3); }

struct Unit { int pm, pn; };
struct Gemm { const bf16_t* A; const bf16_t* Bt; int M, N, K; };

struct StaticOrder {
    int nM, nN, nwg, G, c;
    __host__ __device__ void init(int M, int N, int G_, int c_) { nM = M / BM; nN = N / BM; nwg = nM * nN; G = G_; c = c_; }
    __host__ __device__ bool next(int i, Unit& u) const {
        const long L = (long)i * G + c; if (L >= nwg) return false;
        int wgid = (int)L; { const int q = nwg / NXCD, r = nwg % NXCD, xcd = wgid % NXCD, off = wgid / NXCD; wgid = (xcd < r ? xcd * (q + 1) : r * (q + 1) + (xcd - r) * q) + off; }
        const int nig = WGM * nN, gid = wgid / nig, fm = gid * WGM, gsz = (nM - fm) < WGM ? (nM - fm) : WGM;
        u.pm = fm + ((wgid % nig) % gsz); u.pn = (wgid % nig) / gsz; return true;
    }
    __device__ __forceinline__ void a_ready(const Unit&) const {}
    __device__ __forceinline__ void done(const Unit&) const {}
};

__device__ __forceinline__ unsigned cvt_pk_bf16(float lo, float hi) { unsigned r; asm volatile("v_cvt_pk_bf16_f32 %0, %1, %2" : "=v"(r) : "v"(lo), "v"(hi)); return r; }
typedef float f32x2 __attribute__((ext_vector_type(2)));
struct EpiBf16 {
    static constexpr bool PERM = true, AFTER_DRAIN = false;
    bf16_t* O; int ldc;
    __device__ __forceinline__ void operator()(const f32x4 (&acc)[2][2][4][2], const Unit& u, int wr, int wc, int fr, int fq) const {
        const int row0 = u.pm * BM + wr * 64 + fr, col0 = u.pn * BM + wc * 32 + 8 * fq;
#pragma unroll
        for (int ai = 0; ai < 2; ++ai)
#pragma unroll
            for (int m = 0; m < 4; ++m) { bf16_t* rowp = O + (size_t)(row0 + ai * HALF + m * 16) * ldc + col0;
#pragma unroll
                for (int bj = 0; bj < 2; ++bj) { const f32x4 v0 = acc[ai][bj][m][0], v1 = acc[ai][bj][m][1];
                    u32x4 w; w.x = cvt_pk_bf16(v0[0], v0[1]); w.y = cvt_pk_bf16(v0[2], v0[3]); w.z = cvt_pk_bf16(v1[0], v1[1]); w.w = cvt_pk_bf16(v1[2], v1[3]);
                    *(u32x4*)(rowp + bj * HALF) = w; } }
    }
};
struct EpiSwiGlu {
    static constexpr bool PERM = true, AFTER_DRAIN = false;
    bf16_t* O; int ldc;
    __device__ __forceinline__ void operator()(const f32x4 (&acc)[2][2][4][2], const Unit& u, int wr, int wc, int fr, int fq) const {
        const int row0 = u.pm * BM + wr * 64 + fr, col0 = u.pn * HALF + wc * 32 + 8 * fq;
#pragma unroll
        for (int ai = 0; ai < 2; ++ai)
#pragma unroll
            for (int m = 0; m < 4; ++m) { bf16_t* rowp = O + (size_t)(row0 + ai * HALF + m * 16) * ldc + col0;
                float r[8];
#pragma unroll
                for (int n = 0; n < 2; ++n)
#pragma unroll
                    for (int i = 0; i < 4; ++i) { const float g = acc[ai][0][m][n][i], up = acc[ai][1][m][n][i];
                        r[n * 4 + i] = g * up * __builtin_amdgcn_rcpf(1.0f + __builtin_amdgcn_exp2f(-1.4426950408889634f * g)); }
                u32x4 w; w.x = cvt_pk_bf16(r[0], r[1]); w.y = cvt_pk_bf16(r[2], r[3]); w.z = cvt_pk_bf16(r[4], r[5]); w.w = cvt_pk_bf16(r[6], r[7]);
                *(u32x4*)rowp = w; }
    }
};
struct EpiGateRes {
    static constexpr bool PERM = false, AFTER_DRAIN = false;
    const float* base; float* out; int ldc; const float* gate; int gate_pitch; int tiles_per_batch;
    __device__ __forceinline__ void operator()(const f32x4 (&acc)[2][2][4][2], const Unit& u, int wr, int wc, int fr, int fq) const {
        const int row0 = u.pm * BM + wr * 64 + fr, col0 = u.pn * BM + wc * 32 + 4 * fq;
        const float* g = gate + (size_t)(u.pm / tiles_per_batch) * gate_pitch + col0;
        f32x4 gv[2][2];
#pragma unroll
        for (int bj = 0; bj < 2; ++bj)
#pragma unroll
            for (int n = 0; n < 2; ++n) gv[bj][n] = *(const f32x4*)(g + bj * HALF + n * 16);
#pragma unroll
        for (int ai = 0; ai < 2; ++ai) {
            f32x4 bs[4][2][2];
#pragma unroll
            for (int m = 0; m < 4; ++m) { const size_t off = (size_t)(row0 + ai * HALF + m * 16) * ldc + col0;
#pragma unroll
                for (int bj = 0; bj < 2; ++bj)
#pragma unroll
                    for (int n = 0; n < 2; ++n) bs[m][bj][n] = *(const f32x4*)(base + off + bj * HALF + n * 16); }
            asm volatile("" ::: "memory");
#pragma unroll
            for (int m = 0; m < 4; ++m) { const size_t off = (size_t)(row0 + ai * HALF + m * 16) * ldc + col0;
#pragma unroll
                for (int bj = 0; bj < 2; ++bj)
#pragma unroll
                    for (int n = 0; n < 2; ++n) *(f32x4*)(out + off + bj * HALF + n * 16) = bs[m][bj][n] + gv[bj][n] * acc[ai][bj][m][n]; }
            asm volatile("" ::: "memory"); }
    }
};
struct EpiBf16Rope {
    static constexpr bool PERM = true, AFTER_DRAIN = false;
    bf16_t* O; int ldc; const float* rope; int pn_lo, pn_hi;
    __device__ __forceinline__ void operator()(const f32x4 (&acc)[2][2][4][2], const Unit& u, int wr, int wc, int fr, int fq) const {
        const int row0 = u.pm * BM + wr * 64 + fr;
        if (u.pn < pn_lo || u.pn >= pn_hi) {
            const int col0 = u.pn * BM + wc * 32 + 8 * fq;
#pragma unroll
            for (int ai = 0; ai < 2; ++ai)
#pragma unroll
                for (int m = 0; m < 4; ++m) { bf16_t* rowp = O + (size_t)(row0 + ai * HALF + m * 16) * ldc + col0;
#pragma unroll
                    for (int bj = 0; bj < 2; ++bj) { const f32x4 v0 = acc[ai][bj][m][0], v1 = acc[ai][bj][m][1];
                        u32x4 w; w.x = cvt_pk_bf16(v0[0], v0[1]); w.y = cvt_pk_bf16(v0[2], v0[3]); w.z = cvt_pk_bf16(v1[0], v1[1]); w.w = cvt_pk_bf16(v1[2], v1[3]);
                        *(u32x4*)(rowp + bj * HALF) = w; } }
        } else {
            const int cp = wc * 32 + 8 * fq, d0 = cp & 63, colA = u.pn * BM + (cp < 64 ? cp : cp + 64);
#pragma unroll
            for (int ai = 0; ai < 2; ++ai) {
                f32x4 t[4][4];
#pragma unroll
                for (int m = 0; m < 4; ++m) { const f32x4* cs = (const f32x4*)(rope + ((size_t)(row0 + ai * HALF + m * 16) * 64 + d0) * 2);
                    t[m][0] = cs[0]; t[m][1] = cs[1]; t[m][2] = cs[2]; t[m][3] = cs[3]; }
                asm volatile("" ::: "memory");
#pragma unroll
                for (int m = 0; m < 4; ++m) { const int row = row0 + ai * HALF + m * 16;
                    const f32x4 t0 = t[m][0], t1 = t[m][1], t2 = t[m][2], t3 = t[m][3];
                    const f32x4 a0 = acc[ai][0][m][0], a1 = acc[ai][0][m][1], b0 = acc[ai][1][m][0], b1 = acc[ai][1][m][1];
                    u32x4 w1, w2;
                    w1.x = cvt_pk_bf16(a0[0] * t0[0] - b0[0] * t0[1], a0[1] * t0[2] - b0[1] * t0[3]); w2.x = cvt_pk_bf16(b0[0] * t0[0] + a0[0] * t0[1], b0[1] * t0[2] + a0[1] * t0[3]);
                    w1.y = cvt_pk_bf16(a0[2] * t1[0] - b0[2] * t1[1], a0[3] * t1[2] - b0[3] * t1[3]); w2.y = cvt_pk_bf16(b0[2] * t1[0] + a0[2] * t1[1], b0[3] * t1[2] + a0[3] * t1[3]);
                    w1.z = cvt_pk_bf16(a1[0] * t2[0] - b1[0] * t2[1], a1[1] * t2[2] - b1[1] * t2[3]); w2.z = cvt_pk_bf16(b1[0] * t2[0] + a1[0] * t2[1], b1[1] * t2[2] + a1[1] * t2[3]);
                    w1.w = cvt_pk_bf16(a1[2] * t3[0] - b1[2] * t3[1], a1[3] * t3[2] - b1[3] * t3[3]); w2.w = cvt_pk_bf16(b1[2] * t3[0] + a1[2] * t3[1], b1[3] * t3[2] + a1[3] * t3[3]);
                    bf16_t* rowp = O + (size_t)row * ldc + colA;
                    *(u32x4*)rowp = w1; *(u32x4*)(rowp + 64) = w2; }
                asm volatile("" ::: "memory"); }
        }
    }
};
template <bool BASE16> struct EpiGateResB16 {
    static constexpr bool PERM = true, AFTER_DRAIN = false;
    const void* base; bf16_t* out; int ldc; const float* gate; int gate_pitch; int tiles_per_batch;
    __device__ __forceinline__ void operator()(const f32x4 (&acc)[2][2][4][2], const Unit& u, int wr, int wc, int fr, int fq) const {
        const int row0 = u.pm * BM + wr * 64 + fr, col0 = u.pn * BM + wc * 32 + 8 * fq;
        const float* g = gate + (size_t)(u.pm / tiles_per_batch) * gate_pitch + col0;
        f32x4 gv[2][2];
#pragma unroll
        for (int bj = 0; bj < 2; ++bj)
#pragma unroll
            for (int n = 0; n < 2; ++n) gv[bj][n] = *(const f32x4*)(g + bj * HALF + 4 * n);
#pragma unroll
        for (int ai = 0; ai < 2; ++ai) {
            f32x4 bs[4][2][2];
#pragma unroll
            for (int m = 0; m < 4; ++m) { const size_t off = (size_t)(row0 + ai * HALF + m * 16) * ldc + col0;
#pragma unroll
                for (int bj = 0; bj < 2; ++bj) {
                    if constexpr (BASE16) { const u32x4 w = *(const u32x4*)((const bf16_t*)base + off + bj * HALF);
                        bs[m][bj][0] = (f32x4){__builtin_bit_cast(float, w.x << 16), __builtin_bit_cast(float, w.x & 0xffff0000u), __builtin_bit_cast(float, w.y << 16), __builtin_bit_cast(float, w.y & 0xffff0000u)};
                        bs[m][bj][1] = (f32x4){__builtin_bit_cast(float, w.z << 16), __builtin_bit_cast(float, w.z & 0xffff0000u), __builtin_bit_cast(float, w.w << 16), __builtin_bit_cast(float, w.w & 0xffff0000u)}; }
                    else { bs[m][bj][0] = *(const f32x4*)((const float*)base + off + bj * HALF); bs[m][bj][1] = *(const f32x4*)((const float*)base + off + bj * HALF + 4); } } }
            asm volatile("" ::: "memory");
#pragma unroll
            for (int m = 0; m < 4; ++m) { const size_t off = (size_t)(row0 + ai * HALF + m * 16) * ldc + col0;
#pragma unroll
                for (int bj = 0; bj < 2; ++bj) { const f32x4 v0 = bs[m][bj][0] + gv[bj][0] * acc[ai][bj][m][0], v1 = bs[m][bj][1] + gv[bj][1] * acc[ai][bj][m][1];
                    u32x4 w; w.x = cvt_pk_bf16(v0[0], v0[1]); w.y = cvt_pk_bf16(v0[2], v0[3]); w.z = cvt_pk_bf16(v1[0], v1[1]); w.w = cvt_pk_bf16(v1[2], v1[3]);
                    *(u32x4*)(out + off + bj * HALF) = w; } }
            asm volatile("" ::: "memory"); }
    }
};
template <class Epi, class Sched, bool ALIGN_EPI = false, bool SP2 = false>
__device__ __forceinline__ void gemm_phase(PG8_LAS unsigned char* lds, const Gemm g, const Sched& S, const Epi& E) {
    const int tid = threadIdx.x, wid = __builtin_amdgcn_readfirstlane(tid >> 6), lane = tid & 63, wr = wid >> 2, wc = wid & 3, fr = lane & 15, fq = lane >> 4;
    const int K = g.K, nt = K / BK;
    unsigned voffA[2], voffB[2];
#pragma unroll
    for (int i = 0; i < 2; ++i) { int R, C; stage_rc(tid * 16 + i * 8192, R, C); const int Rb = Epi::PERM ? ((R & ~31) + perm32(R & 31)) : R;
        voffA[i] = (unsigned)(R * K + C) * 2u; voffB[i] = (unsigned)(Rb * K + C) * 2u; }
    const size_t kstep = (size_t)(BK * 2);
    const size_t hstep = (size_t)HALF * K * 2;
    const size_t tstep = 2 * hstep;
    const unsigned ldsw = (unsigned)wid * 1024u;
    const int aoff = lds_byte(wr * 64 + fr, fq * 8), boff = lds_byte(wc * 32 + fr, fq * 8);
#define PG8_SA(b, h) (((b) * 2 + (h)) * HTB)
#define PG8_SB(b, h) ((4 + (b) * 2 + (h)) * HTB)
#define PG8_STAGE(bufoff, gbase, voff) do { _Pragma("unroll") for (int _i = 0; _i < 2; ++_i) \
        __builtin_amdgcn_global_load_lds((const unsigned*)((const char*)(gbase) + (voff)[_i]), (PG8_LAS unsigned*)(lds + (bufoff) + ldsw + _i * 8192), 16, 0, 0); } while (0)
#define PG8_LDA(dst, b, h) do { _Pragma("unroll") for (int m = 0; m < 4; ++m) _Pragma("unroll") for (int k = 0; k < 2; ++k) dst[m][k] = *(const PG8_LAS bf16x8*)(lds + PG8_SA(b, h) + aoff + m * 2048 + k * 1024); } while (0)
#define PG8_LDB(dst, b, h) do { _Pragma("unroll") for (int n = 0; n < 2; ++n) _Pragma("unroll") for (int k = 0; k < 2; ++k) dst[n][k] = *(const PG8_LAS bf16x8*)(lds + PG8_SB(b, h) + boff + n * 2048 + k * 1024); } while (0)
#define PG8_MMA(ai, bj, At, Bt) do { __builtin_amdgcn_s_setprio(1); _Pragma("unroll") for (int m = 0; m < 4; ++m) _Pragma("unroll") for (int n = 0; n < 2; ++n) _Pragma("unroll") for (int k = 0; k < 2; ++k) \
        acc[ai][bj][m][n] = __builtin_amdgcn_mfma_f32_16x16x32_bf16(Bt[n][k], At[m][k], acc[ai][bj][m][n], 0, 0, 0); __builtin_amdgcn_s_setprio(0); } while (0)
#define PG8_WAIT_V(n) asm volatile("s_waitcnt vmcnt(" #n ")" ::: "memory")
#define PG8_WAIT_L(n) asm volatile("s_waitcnt lgkmcnt(" #n ")" ::: "memory")
#define PG8_BAR __builtin_amdgcn_s_barrier()
#define PG8_SCHED __builtin_amdgcn_sched_barrier(0)
    Unit cur, nxt; int ui = 0;
    if (!S.next(0, cur)) return;
    f32x4 acc[2][2][4][2];
#pragma unroll
    for (int a = 0; a < 2; ++a)
#pragma unroll
        for (int b = 0; b < 2; ++b)
#pragma unroll
            for (int m = 0; m < 4; ++m)
#pragma unroll
                for (int n = 0; n < 2; ++n) acc[a][b][m][n] = (f32x4){0.f, 0.f, 0.f, 0.f};
    bf16x8 At[4][2], B0[2][2], B1[2][2];
    const char* cA = (const char*)g.A + (size_t)cur.pm * tstep; const char* cB = (const char*)g.Bt + (size_t)cur.pn * tstep;
    S.a_ready(cur);
    if constexpr (SP2) {
        PG8_STAGE(PG8_SB(0, 0), cB, voffB); PG8_STAGE(PG8_SB(0, 1), cB + hstep, voffB); PG8_STAGE(PG8_SA(0, 0), cA, voffA); PG8_STAGE(PG8_SA(0, 1), cA + hstep, voffA);
        if (wr == 1) PG8_BAR;
        PG8_WAIT_V(2); PG8_BAR;
        PG8_STAGE(PG8_SB(1, 0), cB + kstep, voffB); PG8_STAGE(PG8_SA(1, 0), cA + kstep, voffA); PG8_STAGE(PG8_SB(1, 1), cB + hstep + kstep, voffB);
        PG8_WAIT_V(6); PG8_BAR;
    } else {
        PG8_STAGE(PG8_SB(0, 0), cB, voffB); PG8_STAGE(PG8_SA(0, 0), cA, voffA); PG8_STAGE(PG8_SB(0, 1), cB + hstep, voffB); PG8_STAGE(PG8_SA(0, 1), cA + hstep, voffA);
        if (wr == 1) PG8_BAR;
        PG8_WAIT_V(4); PG8_BAR;
        PG8_STAGE(PG8_SB(1, 0), cB + kstep, voffB); PG8_STAGE(PG8_SA(1, 0), cA + kstep, voffA); PG8_STAGE(PG8_SB(1, 1), cB + hstep + kstep, voffB);
        PG8_WAIT_V(6); PG8_BAR;
    }
    for (;;) {
        const bool has_next = S.next(ui + 1, nxt);
        const char* nA = has_next ? (const char*)g.A + (size_t)nxt.pm * tstep : cA; const char* nB = has_next ? (const char*)g.Bt + (size_t)nxt.pn * tstep : cB;
        for (int t = 0; t < nt; t += 2) {
            const bool last = (t == nt - 2);
            const char* a1 = cA + (size_t)(t + 1) * kstep;
            const char* a2 = last ? nA : cA + (size_t)(t + 2) * kstep; const char* b2 = last ? nB : cB + (size_t)(t + 2) * kstep;
            const char* a3 = a2 + kstep; const char* b3 = b2 + kstep;
            if (last && has_next) S.a_ready(nxt);
            if constexpr (SP2) {
            PG8_LDB(B0, 0, 0); PG8_LDB(B1, 0, 1); PG8_SCHED; PG8_LDA(At, 0, 0); PG8_STAGE(PG8_SA(1, 1), a1 + hstep, voffA);
            PG8_WAIT_V(8); PG8_WAIT_L(0); PG8_BAR; PG8_MMA(0, 0, At, B0); PG8_MMA(0, 1, At, B1); PG8_BAR; PG8_SCHED;
            PG8_LDA(At, 0, 1); PG8_STAGE(PG8_SB(0, 0), b2, voffB); PG8_STAGE(PG8_SB(0, 1), b2 + hstep, voffB); PG8_STAGE(PG8_SA(0, 0), a2, voffA);
            PG8_WAIT_V(8); PG8_WAIT_L(0); PG8_BAR; PG8_MMA(1, 0, At, B0); PG8_MMA(1, 1, At, B1); PG8_BAR; PG8_SCHED;
            PG8_LDB(B0, 1, 0); PG8_LDB(B1, 1, 1); PG8_SCHED; PG8_LDA(At, 1, 0); PG8_STAGE(PG8_SA(0, 1), a2 + hstep, voffA);
            PG8_WAIT_V(8); PG8_WAIT_L(0); PG8_BAR; PG8_MMA(0, 0, At, B0); PG8_MMA(0, 1, At, B1); PG8_BAR; PG8_SCHED;
            PG8_LDA(At, 1, 1); PG8_STAGE(PG8_SB(1, 0), b3, voffB); PG8_STAGE(PG8_SB(1, 1), b3 + hstep, voffB); PG8_STAGE(PG8_SA(1, 0), a3, voffA);
            PG8_WAIT_V(8); PG8_WAIT_L(0); PG8_BAR; PG8_MMA(1, 0, At, B0); PG8_MMA(1, 1, At, B1); PG8_BAR; PG8_SCHED;
            } else {
            PG8_LDB(B0, 0, 0); PG8_SCHED; PG8_LDA(At, 0, 0); PG8_STAGE(PG8_SA(1, 1), a1 + hstep, voffA);
            PG8_WAIT_L(8); PG8_BAR; PG8_WAIT_L(0); PG8_MMA(0, 0, At, B0); PG8_BAR; PG8_SCHED;
            PG8_LDB(B1, 0, 1); PG8_STAGE(PG8_SB(0, 0), b2, voffB);
            PG8_BAR; PG8_WAIT_L(0); PG8_MMA(0, 1, At, B1); PG8_BAR;
            PG8_LDA(At, 0, 1); PG8_STAGE(PG8_SA(0, 0), a2, voffA);
            PG8_BAR; PG8_WAIT_L(0); PG8_MMA(1, 0, At, B0); PG8_BAR; PG8_SCHED;
            PG8_STAGE(PG8_SB(0, 1), b2 + hstep, voffB);
            PG8_WAIT_V(6); PG8_BAR; PG8_MMA(1, 1, At, B1); PG8_BAR;
            PG8_LDB(B0, 1, 0); PG8_SCHED; PG8_LDA(At, 1, 0); PG8_STAGE(PG8_SA(0, 1), a2 + hstep, voffA);
            PG8_WAIT_L(8); PG8_BAR; PG8_WAIT_L(0); PG8_MMA(0, 0, At, B0); PG8_BAR; PG8_SCHED;
            PG8_LDB(B1, 1, 1); PG8_STAGE(PG8_SB(1, 0), b3, voffB);
            PG8_BAR; PG8_WAIT_L(0); PG8_MMA(0, 1, At, B1); PG8_BAR;
            PG8_LDA(At, 1, 1); PG8_STAGE(PG8_SA(1, 0), a3, voffA);
            PG8_BAR; PG8_WAIT_L(0); PG8_MMA(1, 0, At, B0); PG8_BAR; PG8_SCHED;
            PG8_STAGE(PG8_SB(1, 1), b3 + hstep, voffB);
            PG8_WAIT_V(6); PG8_BAR; PG8_MMA(1, 1, At, B1); PG8_BAR;
            }
        }
        if constexpr (ALIGN_EPI) { if (wr == 0) PG8_BAR; }
        if constexpr (!Epi::AFTER_DRAIN) { E(acc, cur, wr, wc, fr, fq); S.done(cur); }
        if (!has_next) break;
#pragma unroll
        for (int a = 0; a < 2; ++a)
#pragma unroll
            for (int b = 0; b < 2; ++b)
#pragma unroll
                for (int m = 0; m < 4; ++m)
#pragma unroll
                    for (int n = 0; n < 2; ++n) acc[a][b][m][n] = (f32x4){0.f, 0.f, 0.f, 0.f};
        cur = nxt; cA = nA; cB = nB; ++ui;
        if constexpr (ALIGN_EPI) { if (wr == 1) PG8_BAR; }
    }
    PG8_WAIT_V(0);
    if constexpr (!ALIGN_EPI) { if (wr == 0) PG8_BAR; }
    PG8_BAR;
    if constexpr (Epi::AFTER_DRAIN) { E.fused(acc, cur, wr, wc, fr, fq, lds, wid, lane); S.done(cur); }
#undef PG8_SA
#undef PG8_SB
#undef PG8_STAGE
#undef PG8_LDA
#undef PG8_LDB
#undef PG8_MMA
#undef PG8_WAIT_V
#undef PG8_WAIT_L
#undef PG8_BAR
#undef PG8_SCHED
}
}
namespace att {
typedef float f32x4v __attribute__((ext_vector_type(4)));
using bf16 = __hip_bfloat16;
constexpr int   D = 128, NW = 8, QBLK = 32, KVBLK = 64;
constexpr float SCALE = 0.088388347648318440f;
constexpr float THR = 8.f;
constexpr int SDEPTH = 2;
constexpr int LDQ = 12288, LDK = 12288, LDO = 2048;
constexpr size_t SHM_V = KVBLK * D * 2, SHM_K = KVBLK * D * 2, SHM_ATTN = 2 * SHM_V + 2 * SHM_K + NW * 64 * 4;
using bf16x8 = __attribute__((ext_vector_type(8))) short;
using s16x4  = __attribute__((ext_vector_type(4))) short;
using f32x16 = __attribute__((ext_vector_type(16))) float;
using f32x8  = __attribute__((ext_vector_type(8))) float;
using u32x4  = __attribute__((ext_vector_type(4))) unsigned;
#define KSWZ(row, colB) ((row) * 256 + ((colB) ^ (((row) & 7) << 4)))
#define SBAR() __builtin_amdgcn_sched_barrier(0)
__device__ __forceinline__ int crow(int r, int hi) { return (r & 3) + 8 * (r >> 2) + 4 * hi; }
__device__ __forceinline__ unsigned cvtpk(float lo, float hi) {
  unsigned r; asm volatile("v_cvt_pk_bf16_f32 %0, %1, %2" : "=v"(r) : "v"(lo), "v"(hi)); return r;
}
template <typename TIn> struct Stage;
template <> struct Stage<bf16>  { using T = bf16x8;
  __device__ static __forceinline__ T ld8(const bf16* p) { return *reinterpret_cast<const bf16x8*>(p); }
  __device__ static __forceinline__ bf16x8 tobf(T x) { return x; } };
template <> struct Stage<float> { using T = f32x8;
  __device__ static __forceinline__ T ld8(const float* p) { return *reinterpret_cast<const f32x8*>(p); }
  __device__ static __forceinline__ bf16x8 tobf(T x) {
    u32x4 w = {cvtpk(x[0], x[1]), cvtpk(x[2], x[3]), cvtpk(x[4], x[5]), cvtpk(x[6], x[7])}; return *reinterpret_cast<bf16x8*>(&w); } };

__device__ __forceinline__ void partialSM(f32x16& p0, f32x16& p1, float& m_reg, float& mn, float& alpha) {
  constexpr float C = SCALE * 1.4426950408889634f;
  float pmax = p0[0]; for (int r = 1; r < 16; ++r) pmax = fmaxf(pmax, p0[r]); for (int r = 0; r < 16; ++r) pmax = fmaxf(pmax, p1[r]);
  { auto rr = __builtin_amdgcn_permlane32_swap(__float_as_uint(pmax), __float_as_uint(pmax), false, false);
    pmax = fmaxf(__uint_as_float(rr[0]), __uint_as_float(rr[1])); }
  if (__builtin_expect(__all(pmax - m_reg <= THR / SCALE), 1)) { mn = m_reg; alpha = 1.f; }
  else { mn = fmaxf(m_reg, pmax); alpha = __builtin_amdgcn_exp2f((m_reg - mn) * C); m_reg = mn; }
  float mnC = -mn * C;
  for (int r = 0; r < 16; ++r) p0[r] = fmaf(p0[r], C, mnC); for (int r = 0; r < 16; ++r) p1[r] = fmaf(p1[r], C, mnC);
  for (int r = 0; r < 16; ++r) p0[r] = __builtin_amdgcn_exp2f(p0[r]);
}
__device__ __forceinline__ void finishSM(f32x16& p0, f32x16& p1, float alpha, float& l_reg, bf16x8& pa0, bf16x8& pa1, bf16x8& pa2, bf16x8& pa3) {
  for (int r = 0; r < 16; ++r) p1[r] = __builtin_amdgcn_exp2f(p1[r]);
  float ps = 0; for (int r = 0; r < 16; ++r) ps += p0[r]; for (int r = 0; r < 16; ++r) ps += p1[r];
  { auto rr = __builtin_amdgcn_permlane32_swap(__float_as_uint(ps), __float_as_uint(ps), false, false);
    ps = __uint_as_float(rr[0]) + __uint_as_float(rr[1]); }
  l_reg = l_reg * alpha + ps;
#define PK4(P, BASE, OUT) do { unsigned a0 = cvtpk(P[BASE + 0], P[BASE + 1]), a1 = cvtpk(P[BASE + 2], P[BASE + 3]);   \
    unsigned b0 = cvtpk(P[BASE + 4], P[BASE + 5]), b1 = cvtpk(P[BASE + 6], P[BASE + 7]);                              \
    auto r0 = __builtin_amdgcn_permlane32_swap(a0, b0, false, false); auto r1 = __builtin_amdgcn_permlane32_swap(a1, b1, false, false); \
    u32x4 w = {r0[0], r1[0], r0[1], r1[1]}; OUT = *reinterpret_cast<bf16x8*>(&w); } while (0)
  PK4(p0, 0, pa0); PK4(p0, 8, pa1); PK4(p1, 0, pa2); PK4(p1, 8, pa3);
#undef PK4
}
__device__ __forceinline__ void qkt(f32x16& p0, f32x16& p1, const bf16* Ks, const bf16x8* qr, int r32, int hi) {
  p0 = f32x16{}; p1 = f32x16{};
  for (int d0 = 0; d0 < 8; ++d0) { int cb = (d0 * 16 + hi * 8) * 2;
    bf16x8 b0 = *reinterpret_cast<const bf16x8*>((const char*)Ks + KSWZ(r32, cb));
    bf16x8 b1 = *reinterpret_cast<const bf16x8*>((const char*)Ks + KSWZ(32 + r32, cb));
    p0 = __builtin_amdgcn_mfma_f32_32x32x16_bf16(b0, qr[d0], p0, 0, 0, 0);
    p1 = __builtin_amdgcn_mfma_f32_32x32x16_bf16(b1, qr[d0], p1, 0, 0, 0); }
}
__device__ __forceinline__ int v_st(int k, int c) { const int kk = (k & ~0xC) | ((k & 4) << 1) | ((k & 8) >> 1); return ((kk >> 3) * 4 + (c >> 5)) * 512 + ((kk & 7) * 32 + (c & 31)) * 2; }
__device__ __forceinline__ int v_rd_base(int lane) { return ((lane & 3) << 3) | (((lane >> 2) & 3) << 6) | (((lane >> 4) & 1) << 5) | (((lane >> 5) & 1) << 8); }
constexpr int v_rd_off(int d0, int ks, int half) { return d0 * 512 + ks * 4096 + half * 2048; }
template <int OFF> __device__ __forceinline__ s16x4 tr_read(int vb) {
  s16x4 r; asm volatile("ds_read_b64_tr_b16 %0, %1 offset:%2" : "=&v"(r) : "v"(vb), "i"(OFF) : "memory"); return r;
}
template <int D0> __device__ __forceinline__ void pv_one(f32x16& od, int vb, bf16x8 pa0, bf16x8 pa1, bf16x8 pa2, bf16x8 pa3) {
  const s16x4 l0 = tr_read<v_rd_off(D0, 0, 0)>(vb), h0 = tr_read<v_rd_off(D0, 0, 1)>(vb), l1 = tr_read<v_rd_off(D0, 1, 0)>(vb), h1 = tr_read<v_rd_off(D0, 1, 1)>(vb);
  const s16x4 l2 = tr_read<v_rd_off(D0, 2, 0)>(vb), h2 = tr_read<v_rd_off(D0, 2, 1)>(vb), l3 = tr_read<v_rd_off(D0, 3, 0)>(vb), h3 = tr_read<v_rd_off(D0, 3, 1)>(vb);
  asm volatile("s_waitcnt lgkmcnt(0)" ::: "memory"); SBAR();
#define PK(L, H) (bf16x8){L[0], L[1], L[2], L[3], H[0], H[1], H[2], H[3]}
  od = __builtin_amdgcn_mfma_f32_32x32x16_bf16(pa0, PK(l0, h0), od, 0, 0, 0);
  od = __builtin_amdgcn_mfma_f32_32x32x16_bf16(pa1, PK(l1, h1), od, 0, 0, 0);
  od = __builtin_amdgcn_mfma_f32_32x32x16_bf16(pa2, PK(l2, h2), od, 0, 0, 0);
  od = __builtin_amdgcn_mfma_f32_32x32x16_bf16(pa3, PK(l3, h3), od, 0, 0, 0);
#undef PK
}
__device__ __forceinline__ void pv_d0(f32x16* o, int vb, bf16x8 pa0, bf16x8 pa1, bf16x8 pa2, bf16x8 pa3) {
  pv_one<0>(o[0], vb, pa0, pa1, pa2, pa3); pv_one<1>(o[1], vb, pa0, pa1, pa2, pa3); pv_one<2>(o[2], vb, pa0, pa1, pa2, pa3); pv_one<3>(o[3], vb, pa0, pa1, pa2, pa3);
}

template <typename TQ>
__device__ __forceinline__ void attn_dense_body(const TQ* __restrict__ Qb, const bf16* __restrict__ Kh, const bf16* __restrict__ Vh,
                                                float* __restrict__ Ob, int seq, char* lds) {
  using St = Stage<bf16>; using SQ = Stage<TQ>;
  const int tid = threadIdx.x, wid = tid >> 6, lane = tid & 63, r32 = lane & 31, hi = lane >> 5;
  bf16* V_lds = (bf16*)lds; bf16* K_lds = (bf16*)(lds + 2 * SHM_V);
  float* ws = (float*)(lds + 2 * SHM_V + 2 * SHM_K) + wid * 64; float* li_l = ws; float* al_l = ws + 32;
  float m_reg = -1e30f, l_reg = 0; f32x16 o[4] = {}; bf16x8 qr[8];
  const TQ* Qw = Qb + (long)(wid * QBLK + r32) * LDQ + hi * 8;
#pragma unroll
  for (int d0 = 0; d0 < 8; ++d0) qr[d0] = SQ::tobf(SQ::ld8(Qw + d0 * 16));
  const int sr = tid >> 4, sc = (tid & 15) * 8, vst0 = v_st(sr, sc), vst1 = v_st(32 + sr, sc);
  const int vb0 = (int)(uintptr_t)V_lds + v_rd_base(lane);
  struct { typename St::T vs0, vs1, ks0, ks1; } sr_[SDEPTH];
#define SLOAD(i, k0) do { sr_[i].vs0 = St::ld8(&Vh[(long)((k0) + sr) * LDK + sc]); sr_[i].vs1 = St::ld8(&Vh[(long)((k0) + 32 + sr) * LDK + sc]); \
    sr_[i].ks0 = St::ld8(&Kh[(long)((k0) + sr) * LDK + sc]); sr_[i].ks1 = St::ld8(&Kh[(long)((k0) + 32 + sr) * LDK + sc]); } while (0)
#define SWRITE(b, i) do { *(bf16x8*)((char*)V_lds + (b) * SHM_V + vst0) = St::tobf(sr_[i].vs0);          \
    *(bf16x8*)((char*)V_lds + (b) * SHM_V + vst1) = St::tobf(sr_[i].vs1); int kc = sc * 2;               \
    *(bf16x8*)((char*)K_lds + (b) * SHM_K + KSWZ(sr, kc)) = St::tobf(sr_[i].ks0);                       \
    *(bf16x8*)((char*)K_lds + (b) * SHM_K + KSWZ(32 + sr, kc)) = St::tobf(sr_[i].ks1); } while (0)
#define SWAIT() do { if constexpr (SDEPTH == 2) asm volatile("s_waitcnt vmcnt(4)" ::: "memory"); else asm volatile("s_waitcnt vmcnt(0)" ::: "memory"); } while (0)
#define RESC(a) do { if (__any((a) < 1.f)) { if (hi == 0) al_l[r32] = (a); asm volatile("s_waitcnt lgkmcnt(0)" ::: "memory"); \
    for (int d = 0; d < 4; ++d) for (int r = 0; r < 16; ++r) o[d][r] *= al_l[crow(r, hi)]; } } while (0)
  f32x16 pA0, pA1, pB0, pB1; float mnA, mnB, alA, alB; bf16x8 pa0, pa1, pa2, pa3; const int NT = seq / KVBLK;
  constexpr int SE = 0, SO = SDEPTH - 1;
  SLOAD(SE, 0); asm volatile("s_waitcnt vmcnt(0)" ::: "memory"); SWRITE(0, SE); __syncthreads();
  qkt(pA0, pA1, K_lds, qr, r32, hi); partialSM(pA0, pA1, m_reg, mnA, alA);
  SLOAD(SO, KVBLK); if constexpr (SDEPTH == 2) { if (2 < NT) SLOAD(SE, 2 * KVBLK); }
  SWAIT(); SWRITE(1, SO); __syncthreads();
  for (int j = 1; j + 1 < NT; j += 2) {
    SBAR(); qkt(pB0, pB1, (bf16*)((char*)K_lds + SHM_K), qr, r32, hi);
    finishSM(pA0, pA1, alA, l_reg, pa0, pa1, pa2, pa3); SBAR();
    SLOAD(SO, (j + SDEPTH) * KVBLK); SBAR();
    pv_d0(o, vb0, pa0, pa1, pa2, pa3); partialSM(pB0, pB1, m_reg, mnB, alB);
    __syncthreads(); SWAIT(); SWRITE(0, SE);
    RESC(alB); __syncthreads();
    SBAR(); qkt(pA0, pA1, K_lds, qr, r32, hi);
    finishSM(pB0, pB1, alB, l_reg, pa0, pa1, pa2, pa3); SBAR();
    if (SDEPTH == 1 || j + 3 < NT) SLOAD(SE, (j + 1 + SDEPTH) * KVBLK); SBAR();
    pv_d0(o, vb0 + (int)SHM_V, pa0, pa1, pa2, pa3); partialSM(pA0, pA1, m_reg, mnA, alA);
    __syncthreads(); SWAIT(); SWRITE(1, SO);
    RESC(alA); __syncthreads();
  }
  SBAR(); qkt(pB0, pB1, (bf16*)((char*)K_lds + SHM_K), qr, r32, hi);
  finishSM(pA0, pA1, alA, l_reg, pa0, pa1, pa2, pa3); SBAR();
  pv_d0(o, vb0, pa0, pa1, pa2, pa3); partialSM(pB0, pB1, m_reg, mnB, alB);
  __syncthreads(); RESC(alB);
  finishSM(pB0, pB1, alB, l_reg, pa0, pa1, pa2, pa3); SBAR();
  pv_d0(o, vb0 + (int)SHM_V, pa0, pa1, pa2, pa3);
  if (hi == 0) li_l[r32] = l_reg; asm volatile("s_waitcnt lgkmcnt(0)" ::: "memory");
  float rli[16];
#pragma unroll
  for (int r = 0; r < 16; ++r) rli[r] = __builtin_amdgcn_rcpf(li_l[crow(r, hi)]);
  float* Ow = Ob + (long)(wid * QBLK) * LDO;
#pragma unroll
  for (int r = 0; r < 16; ++r) { int orow = crow(r, hi);
    for (int d0 = 0; d0 < 4; ++d0) Ow[(long)orow * LDO + d0 * 32 + r32] = o[d0][r] * rli[r]; }
#undef SLOAD
#undef SWRITE
#undef SWAIT
#undef RESC
}

}
namespace att9 {
using bf16 = __hip_bfloat16;
using att::bf16x8; using att::s16x4; using att::f32x16; using att::u32x4; using att::crow; using att::cvtpk; using att::v_rd_base; using att::tr_read;
constexpr int   D = 128, DV = 256, NW = 8, QBLK = 32, KVBLK = 32;
constexpr float SCALE = 0.088388347648318440f;
constexpr float THR = 8.f;
constexpr int LDQ = 12288, LDK = 12288, LDO = 2048;
constexpr size_t SHM_V = KVBLK * DV * 2, SHM_K = KVBLK * D * 2, SHM_ATTN = 4 * SHM_V + 4 * SHM_K + NW * 64 * 4;
__device__ __forceinline__ void partialSM(f32x16& p0, float& m_reg, float& mn, float& alpha) {
  constexpr float C = SCALE * 1.4426950408889634f;
  float pmax = p0[0]; for (int r = 1; r < 16; ++r) pmax = fmaxf(pmax, p0[r]);
  { auto rr = __builtin_amdgcn_permlane32_swap(__float_as_uint(pmax), __float_as_uint(pmax), false, false);
    pmax = fmaxf(__uint_as_float(rr[0]), __uint_as_float(rr[1])); }
  if (__builtin_expect(__all(pmax - m_reg <= THR / SCALE), 1)) { mn = m_reg; alpha = 1.f; }
  else { mn = fmaxf(m_reg, pmax); alpha = __builtin_amdgcn_exp2f((m_reg - mn) * C); m_reg = mn; }
  float mnC = -mn * C;
  for (int r = 0; r < 16; ++r) p0[r] = fmaf(p0[r], C, mnC);
  for (int r = 0; r < 8; ++r) p0[r] = __builtin_amdgcn_exp2f(p0[r]);
}
__device__ __forceinline__ void finishSM(f32x16& p0, float alpha, float& l_reg, bf16x8& pa0, bf16x8& pa1) {
  for (int r = 8; r < 16; ++r) p0[r] = __builtin_amdgcn_exp2f(p0[r]);
  float ps = 0; for (int r = 0; r < 16; ++r) ps += p0[r];
  { auto rr = __builtin_amdgcn_permlane32_swap(__float_as_uint(ps), __float_as_uint(ps), false, false);
    ps = __uint_as_float(rr[0]) + __uint_as_float(rr[1]); }
  l_reg = l_reg * alpha + ps;
#define PK4(P, BASE, OUT) do { unsigned a0 = cvtpk(P[BASE + 0], P[BASE + 1]), a1 = cvtpk(P[BASE + 2], P[BASE + 3]);   \
    unsigned b0 = cvtpk(P[BASE + 4], P[BASE + 5]), b1 = cvtpk(P[BASE + 6], P[BASE + 7]);                              \
    auto r0 = __builtin_amdgcn_permlane32_swap(a0, b0, false, false); auto r1 = __builtin_amdgcn_permlane32_swap(a1, b1, false, false); \
    u32x4 w = {r0[0], r1[0], r0[1], r1[1]}; OUT = *reinterpret_cast<bf16x8*>(&w); } while (0)
  PK4(p0, 0, pa0); PK4(p0, 8, pa1);
#undef PK4
}
__device__ __forceinline__ void qkt(f32x16& p0, const bf16* Ks, const bf16x8* qr, int r32, int hi) {
  p0 = f32x16{};
  int swz = ((r32 & 15) << 4) ^ (hi << 4); asm volatile("" : "+v"(swz));
  const char* kr = (const char*)Ks + r32 * 256;
  for (int d0 = 0; d0 < 8; ++d0) {
    bf16x8 b0 = *reinterpret_cast<const bf16x8*>(kr + ((d0 * 32) ^ swz));
    p0 = __builtin_amdgcn_mfma_f32_32x32x16_bf16(b0, qr[d0], p0, 0, 0, 0); }
}
__device__ __forceinline__ int v_st(int k, int c) { const int kk = (k & ~0xC) | ((k & 4) << 1) | ((k & 8) >> 1); return ((kk >> 3) * 8 + (c >> 5)) * 512 + ((kk & 7) * 32 + (c & 31)) * 2; }
constexpr int v_rd_off(int d0, int ks, int half) { return d0 * 512 + (2 * ks + half) * 4096; }
template <int D0> __device__ __forceinline__ void pv_two(f32x16& oa, f32x16& ob, int vb, bf16x8 pa0, bf16x8 pa1) {
  const s16x4 l0 = tr_read<v_rd_off(D0, 0, 0)>(vb), h0 = tr_read<v_rd_off(D0, 0, 1)>(vb), l1 = tr_read<v_rd_off(D0, 1, 0)>(vb), h1 = tr_read<v_rd_off(D0, 1, 1)>(vb);
  const s16x4 l2 = tr_read<v_rd_off(D0 + 1, 0, 0)>(vb), h2 = tr_read<v_rd_off(D0 + 1, 0, 1)>(vb), l3 = tr_read<v_rd_off(D0 + 1, 1, 0)>(vb), h3 = tr_read<v_rd_off(D0 + 1, 1, 1)>(vb);
  asm volatile("s_waitcnt lgkmcnt(0)" ::: "memory"); SBAR();
#define PK(L, H) (bf16x8){L[0], L[1], L[2], L[3], H[0], H[1], H[2], H[3]}
  oa = __builtin_amdgcn_mfma_f32_32x32x16_bf16(pa0, PK(l0, h0), oa, 0, 0, 0);
  ob = __builtin_amdgcn_mfma_f32_32x32x16_bf16(pa0, PK(l2, h2), ob, 0, 0, 0);
  oa = __builtin_amdgcn_mfma_f32_32x32x16_bf16(pa1, PK(l1, h1), oa, 0, 0, 0);
  ob = __builtin_amdgcn_mfma_f32_32x32x16_bf16(pa1, PK(l3, h3), ob, 0, 0, 0);
#undef PK
}
template <int D0> __device__ __forceinline__ void pv_one(f32x16& oa, int vb, bf16x8 pa0, bf16x8 pa1) {
  const s16x4 l0 = tr_read<v_rd_off(D0, 0, 0)>(vb), h0 = tr_read<v_rd_off(D0, 0, 1)>(vb), l1 = tr_read<v_rd_off(D0, 1, 0)>(vb), h1 = tr_read<v_rd_off(D0, 1, 1)>(vb);
  asm volatile("s_waitcnt lgkmcnt(0)" ::: "memory"); SBAR();
#define PK(L, H) (bf16x8){L[0], L[1], L[2], L[3], H[0], H[1], H[2], H[3]}
  oa = __builtin_amdgcn_mfma_f32_32x32x16_bf16(pa0, PK(l0, h0), oa, 0, 0, 0);
  oa = __builtin_amdgcn_mfma_f32_32x32x16_bf16(pa1, PK(l1, h1), oa, 0, 0, 0);
#undef PK
}
__device__ __forceinline__ void pv_all(f32x16* o, int vb, bf16x8 pa0, bf16x8 pa1) {
  pv_two<0>(o[0], o[1], vb, pa0, pa1); pv_two<2>(o[2], o[3], vb, pa0, pa1); pv_two<4>(o[4], o[5], vb, pa0, pa1); pv_two<6>(o[6], o[7], vb, pa0, pa1);
}
__device__ __forceinline__ void attn_body(const int MODE, const bf16* __restrict__ Qb, const bf16* __restrict__ Kh, const bf16* __restrict__ Vh, float* Ob, unsigned short* Yb,
                                                              float lam, const float* subg, int seq, char* lds) {
  int tid_ = threadIdx.x; asm volatile("" : "+v"(tid_));
  const int tid = tid_, wid = tid >> 6, lane = tid & 63, r32 = lane & 31, hi = lane >> 5;
  bf16* V_lds = (bf16*)lds; bf16* K_lds = (bf16*)(lds + 4 * SHM_V);
  float* ws = (float*)(lds + 4 * SHM_V + 4 * SHM_K) + wid * 64; float* li_l = ws; float* al_l = ws + 32;
  float m_reg = -1e30f, l_reg = 0; f32x16 o[8] = {}; bf16x8 qr[8];
  const bf16* Qw = Qb + (long)(wid * QBLK + r32) * LDQ + hi * 8;
#pragma unroll
  for (int d0 = 0; d0 < 8; ++d0) qr[d0] = *reinterpret_cast<const bf16x8*>(Qw + d0 * 16);
  const int vb0 = (int)(uintptr_t)V_lds + v_rd_base(lane);
  const int krow = 4 * wid + (lane >> 4), gK = (krow * LDK) * 2 + (((lane & 15) ^ (krow & 15)) << 4);
  int gV[2];
#pragma unroll
  for (int q = 0; q < 2; ++q) { const int S = 2 * (2 * wid + q) + (lane >> 5), kk = (S >> 3) * 8 + ((lane & 31) >> 2), key = (kk & ~0xC) | ((kk & 4) << 1) | ((kk & 8) >> 1);
    gV[q] = (key * LDK + (S & 7) * 32 + (lane & 3) * 8) * 2; }
  typedef __attribute__((address_space(3))) unsigned lds_u32;
  const unsigned ldsK = (unsigned)(uintptr_t)K_lds + (unsigned)wid * 1024u, ldsV = (unsigned)(uintptr_t)V_lds + (unsigned)wid * 2048u;
#define DMA(k0, slot) do { const long to_ = (long)(k0) * (LDK * 2); const unsigned so_ = (unsigned)(slot); \
    __builtin_amdgcn_global_load_lds((const unsigned*)((const char*)Kh + to_ + gK), (lds_u32*)(uintptr_t)(ldsK + so_ * (unsigned)SHM_K), 16, 0, 0); \
    __builtin_amdgcn_global_load_lds((const unsigned*)((const char*)Vh + to_ + gV[0]), (lds_u32*)(uintptr_t)(ldsV + so_ * (unsigned)SHM_V), 16, 0, 0); \
    __builtin_amdgcn_global_load_lds((const unsigned*)((const char*)Vh + to_ + gV[1]), (lds_u32*)(uintptr_t)(ldsV + so_ * (unsigned)SHM_V + 1024u), 16, 0, 0); } while (0)
#define BAR_AFTER(N) do { asm volatile("s_waitcnt vmcnt(" #N ")" ::: "memory"); __builtin_amdgcn_s_barrier(); asm volatile("" ::: "memory"); SBAR(); } while (0)
#define RESC(a) do { if (__any((a) < 1.f)) { if (hi == 0) al_l[r32] = (a); asm volatile("s_waitcnt lgkmcnt(0)" ::: "memory"); \
    _Pragma("unroll") for (int rg = 0; rg < 4; ++rg) { const float a0_ = al_l[crow(4 * rg, hi)], a1_ = al_l[crow(4 * rg + 1, hi)], a2_ = al_l[crow(4 * rg + 2, hi)], a3_ = al_l[crow(4 * rg + 3, hi)]; \
      _Pragma("unroll") for (int d = 0; d < 8; ++d) { o[d][4 * rg] *= a0_; o[d][4 * rg + 1] *= a1_; o[d][4 * rg + 2] *= a2_; o[d][4 * rg + 3] *= a3_; } asm volatile("" ::: "memory"); } } } while (0)
  f32x16 pA, pB; float mnA, mnB, alA, alB; bf16x8 pa0, pa1; const int NT = seq / KVBLK;
  if (wid >= 4) __builtin_amdgcn_s_setprio(1);
  DMA(0, 0); DMA(KVBLK, 1); BAR_AFTER(0);
  qkt(pA, K_lds, qr, r32, hi); partialSM(pA, m_reg, mnA, alA);
  DMA(2 * KVBLK, 2);
  for (int j = 1; j + 1 < NT; j += 2) {
    DMA((j + 2) * KVBLK, (j + 2) & 3); SBAR();
    qkt(pB, (bf16*)((char*)K_lds + (j & 3) * SHM_K), qr, r32, hi);
    finishSM(pA, alA, l_reg, pa0, pa1); SBAR();
    pv_all(o, vb0 + ((j - 1) & 3) * (int)SHM_V, pa0, pa1); partialSM(pB, m_reg, mnB, alB);
    RESC(alB); BAR_AFTER(3);
    if (j + 3 < NT) { DMA((j + 3) * KVBLK, (j + 3) & 3); } SBAR();
    qkt(pA, (bf16*)((char*)K_lds + ((j + 1) & 3) * SHM_K), qr, r32, hi);
    finishSM(pB, alB, l_reg, pa0, pa1); SBAR();
    pv_all(o, vb0 + (j & 3) * (int)SHM_V, pa0, pa1); partialSM(pA, m_reg, mnA, alA);
    RESC(alA);
    if (j + 3 < NT) BAR_AFTER(3); else BAR_AFTER(0);
  }
  SBAR(); qkt(pB, (bf16*)((char*)K_lds + ((NT - 1) & 3) * SHM_K), qr, r32, hi);
  finishSM(pA, alA, l_reg, pa0, pa1); SBAR();
  pv_all(o, vb0 + ((NT - 2) & 3) * (int)SHM_V, pa0, pa1); partialSM(pB, m_reg, mnB, alB);
  RESC(alB);
  finishSM(pB, alB, l_reg, pa0, pa1); SBAR();
  pv_all(o, vb0 + ((NT - 1) & 3) * (int)SHM_V, pa0, pa1);
  __builtin_amdgcn_s_setprio(0);
  if (hi == 0) li_l[r32] = l_reg; asm volatile("s_waitcnt lgkmcnt(0)" ::: "memory");
  int lo_ = tid; asm volatile("" : "+v"(lo_));
  float rl[16];
#pragma unroll
  for (int r = 0; r < 16; ++r) rl[r] = __builtin_amdgcn_rcpf(li_l[crow(r, hi)]);
  if (MODE == 0) {
    __attribute__((address_space(1))) att::f32x4v* sp = (__attribute__((address_space(1))) att::f32x4v*)Ob + lo_;
#pragma unroll
    for (int g = 0; g < 32; ++g) { const int d0 = g >> 2, q = g & 3;
      *sp = (att::f32x4v){o[d0][4 * q] * rl[4 * q], o[d0][4 * q + 1] * rl[4 * q + 1], o[d0][4 * q + 2] * rl[4 * q + 2], o[d0][4 * q + 3] * rl[4 * q + 3]};
      sp += 512; asm volatile("" : "+v"(sp)); }
  } else {
    float ss[16];
#pragma unroll
    for (int r = 0; r < 16; ++r) { ss[r] = 0.f; rl[r] *= lam; }
    { const __attribute__((address_space(1))) att::f32x4v* sp = (const __attribute__((address_space(1))) att::f32x4v*)Ob + lo_;
#pragma unroll
      for (int g = 0; g < 32; ++g) { const int d0 = g >> 2, q = g & 3; const att::f32x4v a4 = *sp; sp += 512; asm volatile("" : "+v"(sp));
#pragma unroll
        for (int i = 0; i < 4; ++i) { const float d = a4[i] - o[d0][4 * q + i] * rl[4 * q + i]; ss[4 * q + i] += d * d; }
        if ((g & 7) == 7) asm volatile("" ::: "memory"); } }
#pragma unroll
    for (int r = 0; r < 16; ++r) {
#pragma unroll
      for (int off = 1; off < 32; off <<= 1) ss[r] += __shfl_xor(ss[r], off);
      ss[r] = 0.8f / sqrtf(ss[r] * (1.0f / 256.0f) + 1e-5f); }
    float gs[8];
#pragma unroll
    for (int d0 = 0; d0 < 8; ++d0) gs[d0] = subg[d0 * 32 + (lo_ & 31)];
    unsigned short* Yw = Yb + (long)(wid * QBLK + 4 * ((lo_ >> 5) & 1)) * 4096 + (lo_ & 31);
    { const __attribute__((address_space(1))) att::f32x4v* sp = (const __attribute__((address_space(1))) att::f32x4v*)Ob + lo_;
#pragma unroll
      for (int g = 0; g < 32; ++g) { const int d0 = g >> 2, q = g & 3; const att::f32x4v a4 = *sp; sp += 512; asm volatile("" : "+v"(sp));
#pragma unroll
        for (int i = 0; i < 4; ++i) { const int r = 4 * q + i; const float y = (a4[i] - o[d0][r] * rl[r]) * ss[r] * gs[d0];
          unsigned u = __float_as_uint(y); u = (u + 0x7fffu + ((u >> 16) & 1u)) >> 16; Yw[((r & 3) + 8 * (r >> 2)) * 4096 + d0 * 32] = (unsigned short)u; }
        if ((g & 7) == 7) asm volatile("" ::: "memory"); } }
  }
#undef DMA
#undef BAR_AFTER
#undef RESC
}
}
namespace att16 {
using bf16 = __hip_bfloat16;
using att::bf16x8; using att::s16x4; using att::u32x4; using att::cvtpk; using att::tr_read;
typedef float f32x4 __attribute__((ext_vector_type(4)));
constexpr int   D = 128, DV = 256, NW = 8, QBLK = 32, KVBLK = 32;
constexpr float SCALE = 0.088388347648318440f;
constexpr float THR = 8.f;
constexpr int LDQ = 12288, LDK = 12288;
constexpr size_t SHM_V = KVBLK * DV * 2, SHM_K = KVBLK * D * 2, SHM_ATTN = 4 * SHM_V + 4 * SHM_K;
#define MF16(A, B, C) __builtin_amdgcn_mfma_f32_16x16x32_bf16(A, B, C, 0, 0, 0)
__device__ __forceinline__ float vmax3(float a, float b, float c) { float r; asm("v_max3_f32 %0, %1, %2, %3" : "=v"(r) : "v"(a), "v"(b), "v"(c)); return r; }
__device__ __forceinline__ float vmax2(float a, float b) { float r; asm("v_max_f32 %0, %1, %2" : "=v"(r) : "v"(a), "v"(b)); return r; }
__device__ __forceinline__ float max8(const f32x4& a, const f32x4& b) { return vmax2(vmax3(vmax3(vmax3(a[0], a[1], a[2]), a[3], b[0]), b[1], b[2]), b[3]); }
__device__ __forceinline__ void partialSM(f32x4 (&s)[2][2], float (&m_reg)[2], float (&l_reg)[2], f32x4 (&o)[2][16]) {
  constexpr float C = SCALE * 1.4426950408889634f;
  float pm0 = max8(s[0][0], s[1][0]), pm1 = max8(s[0][1], s[1][1]);
  if (__builtin_expect(!__all((pm0 - m_reg[0] <= THR / SCALE) && (pm1 - m_reg[1] <= THR / SCALE)), 0)) {
    pm0 = fmaxf(pm0, __shfl_xor(pm0, 16)); pm0 = fmaxf(pm0, __shfl_xor(pm0, 32)); pm1 = fmaxf(pm1, __shfl_xor(pm1, 16)); pm1 = fmaxf(pm1, __shfl_xor(pm1, 32));
    const float n0 = fmaxf(m_reg[0], pm0), a0 = __builtin_amdgcn_exp2f((m_reg[0] - n0) * C), n1 = fmaxf(m_reg[1], pm1), a1 = __builtin_amdgcn_exp2f((m_reg[1] - n1) * C);
    m_reg[0] = n0; m_reg[1] = n1; l_reg[0] *= a0; l_reg[1] *= a1;
#pragma unroll
    for (int dt = 0; dt < 16; ++dt) { o[0][dt] *= a0; o[1][dt] *= a1; } }
  const float c0 = -m_reg[0] * C, c1 = -m_reg[1] * C;
#pragma unroll
  for (int t = 0; t < 2; ++t)
#pragma unroll
    for (int i = 0; i < 4; ++i) { s[t][0][i] = fmaf(s[t][0][i], C, c0); s[t][1][i] = fmaf(s[t][1][i], C, c1); }
#pragma unroll
  for (int i = 0; i < 4; ++i) { s[0][0][i] = __builtin_amdgcn_exp2f(s[0][0][i]); s[0][1][i] = __builtin_amdgcn_exp2f(s[0][1][i]); }
}
__device__ __forceinline__ void finishSM(f32x4 (&s)[2][2], float (&l_reg)[2], bf16x8 (&pf)[2]) {
#pragma unroll
  for (int i = 0; i < 4; ++i) { s[1][0][i] = __builtin_amdgcn_exp2f(s[1][0][i]); s[1][1][i] = __builtin_amdgcn_exp2f(s[1][1][i]); }
#pragma unroll
  for (int u = 0; u < 2; ++u) {
    const float ps = ((s[0][u][0] + s[0][u][1]) + (s[0][u][2] + s[0][u][3])) + ((s[1][u][0] + s[1][u][1]) + (s[1][u][2] + s[1][u][3]));
    l_reg[u] += ps;
    u32x4 w = {cvtpk(s[0][u][0], s[0][u][1]), cvtpk(s[0][u][2], s[0][u][3]), cvtpk(s[1][u][0], s[1][u][1]), cvtpk(s[1][u][2], s[1][u][3])}; pf[u] = *reinterpret_cast<bf16x8*>(&w); }
}
__device__ __forceinline__ void qkt(f32x4 (&s)[2][2], const bf16* Ks, const bf16x8 (&qr)[2][4], int j16, int g) {
  s[0][0] = f32x4{}; s[0][1] = f32x4{}; s[1][0] = f32x4{}; s[1][1] = f32x4{};
  int swz = (g ^ j16) << 4; asm volatile("" : "+v"(swz));
  const char* kr = (const char*)Ks + j16 * 256;
#pragma unroll
  for (int db = 0; db < 4; ++db) { const int x = (db * 64) ^ swz;
    const bf16x8 k0 = *reinterpret_cast<const bf16x8*>(kr + x), k1 = *reinterpret_cast<const bf16x8*>(kr + 4096 + x);
    s[0][0] = MF16(k0, qr[0][db], s[0][0]); s[0][1] = MF16(k0, qr[1][db], s[0][1]);
    s[1][0] = MF16(k1, qr[0][db], s[1][0]); s[1][1] = MF16(k1, qr[1][db], s[1][1]); }
}
constexpr int v_off(int dt, int t) { return (dt >> 1) * 2048 + t * 1024; }
#define PK(L, H) (bf16x8){L[0], L[1], L[2], L[3], H[0], H[1], H[2], H[3]}
template <int DT0> __device__ __forceinline__ void pv_grp(f32x4 (&o)[2][16], int vbE, int vbO, const bf16x8 (&pf)[2]) {
  const s16x4 a0 = tr_read<v_off(DT0, 0)>(vbE), a1 = tr_read<v_off(DT0, 1)>(vbE), b0 = tr_read<v_off(DT0 + 1, 0)>(vbO), b1 = tr_read<v_off(DT0 + 1, 1)>(vbO);
  const s16x4 c0 = tr_read<v_off(DT0 + 2, 0)>(vbE), c1 = tr_read<v_off(DT0 + 2, 1)>(vbE), d0 = tr_read<v_off(DT0 + 3, 0)>(vbO), d1 = tr_read<v_off(DT0 + 3, 1)>(vbO);
  asm volatile("s_waitcnt lgkmcnt(0)" ::: "memory"); SBAR();
  { const bf16x8 v = PK(a0, a1); o[0][DT0] = MF16(v, pf[0], o[0][DT0]); o[1][DT0] = MF16(v, pf[1], o[1][DT0]); }
  { const bf16x8 v = PK(b0, b1); o[0][DT0 + 1] = MF16(v, pf[0], o[0][DT0 + 1]); o[1][DT0 + 1] = MF16(v, pf[1], o[1][DT0 + 1]); }
  { const bf16x8 v = PK(c0, c1); o[0][DT0 + 2] = MF16(v, pf[0], o[0][DT0 + 2]); o[1][DT0 + 2] = MF16(v, pf[1], o[1][DT0 + 2]); }
  { const bf16x8 v = PK(d0, d1); o[0][DT0 + 3] = MF16(v, pf[0], o[0][DT0 + 3]); o[1][DT0 + 3] = MF16(v, pf[1], o[1][DT0 + 3]); }
}
#undef PK
__device__ __forceinline__ void pv_all(f32x4 (&o)[2][16], int vbE, const bf16x8 (&pf)[2]) {
  int vbO = vbE ^ 32; asm volatile("" : "+v"(vbO));
  pv_grp<0>(o, vbE, vbO, pf); pv_grp<4>(o, vbE, vbO, pf); pv_grp<8>(o, vbE, vbO, pf); pv_grp<12>(o, vbE, vbO, pf);
}
template <int OFF> __device__ __forceinline__ bf16x8 k_read(int ka) { bf16x8 r; asm volatile("ds_read_b128 %0, %1 offset:%2" : "=&v"(r) : "v"(ka), "i"(OFF) : "memory"); return r; }
__device__ __forceinline__ void k_load(bf16x8 (&kf)[2][4], int kb, int j16, int g) {
  int swz = (g ^ j16) << 4; asm volatile("" : "+v"(swz));
  const int kr = kb + j16 * 256;
  { const int a = kr + (0 ^ swz);   kf[0][0] = k_read<0>(a); kf[1][0] = k_read<4096>(a); }
  { const int a = kr + (64 ^ swz);  kf[0][1] = k_read<0>(a); kf[1][1] = k_read<4096>(a); }
  { const int a = kr + (128 ^ swz); kf[0][2] = k_read<0>(a); kf[1][2] = k_read<4096>(a); }
  { const int a = kr + (192 ^ swz); kf[0][3] = k_read<0>(a); kf[1][3] = k_read<4096>(a); }
}
__device__ __forceinline__ void qk_mma(f32x4 (&s)[2][2], const bf16x8 (&kf)[2][4], const bf16x8 (&qr)[2][4]) {
  s[0][0] = f32x4{}; s[0][1] = f32x4{}; s[1][0] = f32x4{}; s[1][1] = f32x4{};
#pragma unroll
  for (int db = 0; db < 4; ++db) {
    s[0][0] = MF16(kf[0][db], qr[0][db], s[0][0]); s[0][1] = MF16(kf[0][db], qr[1][db], s[0][1]);
    s[1][0] = MF16(kf[1][db], qr[0][db], s[1][0]); s[1][1] = MF16(kf[1][db], qr[1][db], s[1][1]); }
}
template <int DT0> __device__ __forceinline__ void pv_rd(int vbE, int vbO, s16x4 (&f)[8]) {
  f[0] = tr_read<v_off(DT0, 0)>(vbE); f[1] = tr_read<v_off(DT0, 1)>(vbE); f[2] = tr_read<v_off(DT0 + 1, 0)>(vbO); f[3] = tr_read<v_off(DT0 + 1, 1)>(vbO);
  f[4] = tr_read<v_off(DT0 + 2, 0)>(vbE); f[5] = tr_read<v_off(DT0 + 2, 1)>(vbE); f[6] = tr_read<v_off(DT0 + 3, 0)>(vbO); f[7] = tr_read<v_off(DT0 + 3, 1)>(vbO);
}
#define PK(L, H) (bf16x8){L[0], L[1], L[2], L[3], H[0], H[1], H[2], H[3]}
template <int DT0> __device__ __forceinline__ void pv_mm(f32x4 (&o)[2][16], const s16x4 (&f)[8], const bf16x8 (&pf)[2]) {
#pragma unroll
  for (int i = 0; i < 4; ++i) { const bf16x8 v = PK(f[2 * i], f[2 * i + 1]); o[0][DT0 + i] = MF16(v, pf[0], o[0][DT0 + i]); o[1][DT0 + i] = MF16(v, pf[1], o[1][DT0 + i]); }
}
#undef PK
__device__ __forceinline__ void attn_body(const int MODE, const bf16* __restrict__ Qb, const bf16* __restrict__ Kh, const bf16* __restrict__ Vh, float* Ob, unsigned short* Yb,
                                          float lam, const float* subg, int seq, char* lds) {
  int tid_ = threadIdx.x; asm volatile("" : "+v"(tid_));
  const int tid = tid_, wid = tid >> 6, lane = tid & 63, j16 = lane & 15, g = lane >> 4;
  bf16* V_lds = (bf16*)lds; bf16* K_lds = (bf16*)(lds + 4 * SHM_V);
  float m_reg[2] = {-1e30f, -1e30f}, l_reg[2] = {0.f, 0.f}; f32x4 o[2][16]; bf16x8 qr[2][4];
#pragma unroll
  for (int u = 0; u < 2; ++u)
#pragma unroll
    for (int dt = 0; dt < 16; ++dt) o[u][dt] = f32x4{};
#pragma unroll
  for (int u = 0; u < 2; ++u)
#pragma unroll
    for (int db = 0; db < 4; ++db) qr[u][db] = *reinterpret_cast<const bf16x8*>(Qb + (long)(wid * QBLK + 16 * u + j16) * LDQ + db * 32 + g * 8);
  const int vrb = (4 * g + (j16 >> 2)) * 64 + 8 * (j16 & 3) + (g & 1) * 32;
  const int vbE0 = (int)(uintptr_t)V_lds + vrb;
  const int krow = 4 * wid + (lane >> 4), gK = (krow * LDK) * 2 + (((lane & 15) ^ (krow & 15)) << 4);
  const int gV0 = ((lane >> 2) * LDK + wid * 32 + ((((lane >> 1) ^ (lane >> 4)) & 1) * 16) + (lane & 1) * 8) * 2;
  typedef __attribute__((address_space(3))) unsigned lds_u32;
  const unsigned ldsK = (unsigned)(uintptr_t)K_lds + (unsigned)wid * 1024u, ldsV = (unsigned)(uintptr_t)V_lds + (unsigned)wid * 2048u;
#define DMA(k0, slot) do { const long to_ = (long)(k0) * (LDK * 2); const unsigned so_ = (unsigned)(slot); \
    __builtin_amdgcn_global_load_lds((const unsigned*)((const char*)Kh + to_ + gK), (lds_u32*)(uintptr_t)(ldsK + so_ * (unsigned)SHM_K), 16, 0, 0); \
    __builtin_amdgcn_global_load_lds((const unsigned*)((const char*)Vh + to_ + gV0), (lds_u32*)(uintptr_t)(ldsV + so_ * (unsigned)SHM_V), 16, 0, 0); \
    __builtin_amdgcn_global_load_lds((const unsigned*)((const char*)Vh + (to_ + 16L * LDK * 2) + gV0), (lds_u32*)(uintptr_t)(ldsV + so_ * (unsigned)SHM_V + 1024u), 16, 0, 0); } while (0)
#define BAR_AFTER(N) do { asm volatile("s_waitcnt vmcnt(" #N ")" ::: "memory"); __builtin_amdgcn_s_barrier(); asm volatile("" ::: "memory"); SBAR(); } while (0)
  f32x4 pA[2][2], pB[2][2]; bf16x8 pf[2]; const int NT = seq / KVBLK;
  if (wid >= 4) __builtin_amdgcn_s_setprio(1);
  DMA(0, 0); DMA(KVBLK, 1); BAR_AFTER(0);
  qkt(pA, K_lds, qr, j16, g); SBAR();
  asm volatile("s_nop 7\n\ts_nop 7\n\ts_nop 7" ::: "memory"); SBAR();
  partialSM(pA, m_reg, l_reg, o);
  DMA(2 * KVBLK, 2);
#define LWAIT() do { asm volatile("s_waitcnt lgkmcnt(0)" ::: "memory"); SBAR(); } while (0)
#define STEP(pN, pO, kslot, vslot) do { bf16x8 kf[2][4]; s16x4 fa[8], fb[8]; \
    k_load(kf, (int)(uintptr_t)K_lds + (kslot) * (int)SHM_K, j16, g); finishSM(pO, l_reg, pf); LWAIT(); \
    const int vE = vbE0 + (vslot) * (int)SHM_V; int vO = vE ^ 32; asm volatile("" : "+v"(vO)); \
    pv_rd<0>(vE, vO, fa); qk_mma(pN, kf, qr); LWAIT(); \
    pv_rd<4>(vE, vO, fb); pv_mm<0>(o, fa, pf); LWAIT(); \
    pv_rd<8>(vE, vO, fa); pv_mm<4>(o, fb, pf); LWAIT(); \
    pv_rd<12>(vE, vO, fb); pv_mm<8>(o, fa, pf); LWAIT(); \
    pv_mm<12>(o, fb, pf); partialSM(pN, m_reg, l_reg, o); } while (0)
  for (int j = 1; j + 1 < NT; j += 2) {
    DMA((j + 2) * KVBLK, (j + 2) & 3); SBAR();
    STEP(pB, pA, j & 3, (j - 1) & 3);
    BAR_AFTER(3);
    if (j + 3 < NT) { DMA((j + 3) * KVBLK, (j + 3) & 3); } SBAR();
    STEP(pA, pB, (j + 1) & 3, j & 3);
    if (j + 3 < NT) BAR_AFTER(3); else BAR_AFTER(0);
  }
  SBAR(); STEP(pB, pA, (NT - 1) & 3, (NT - 2) & 3);
  finishSM(pB, l_reg, pf); SBAR();
  pv_all(o, vbE0 + ((NT - 1) & 3) * (int)SHM_V, pf);
#undef STEP
#undef LWAIT
  __builtin_amdgcn_s_setprio(0);
  int lo_ = tid; asm volatile("" : "+v"(lo_));
  float rl[2];
#pragma unroll
  for (int u = 0; u < 2; ++u) { float x = l_reg[u]; x += __shfl_xor(x, 16); x += __shfl_xor(x, 32); rl[u] = __builtin_amdgcn_rcpf(x); }
  if (MODE == 0) {
    __attribute__((address_space(1))) f32x4* sp = (__attribute__((address_space(1))) f32x4*)Ob + lo_;
#pragma unroll
    for (int s = 0; s < 32; ++s) { const int u = s >> 4, dt = s & 15; *sp = o[u][dt] * rl[u]; sp += 512; asm volatile("" : "+v"(sp)); }
  } else {
    float ss[2] = {0.f, 0.f}; rl[0] *= lam; rl[1] *= lam;
    { const __attribute__((address_space(1))) f32x4* sp = (const __attribute__((address_space(1))) f32x4*)Ob + lo_;
#pragma unroll
      for (int s = 0; s < 32; ++s) { const int u = s >> 4, dt = s & 15; const f32x4 a4 = *sp; sp += 512; asm volatile("" : "+v"(sp));
#pragma unroll
        for (int i = 0; i < 4; ++i) { const float d = a4[i] - o[u][dt][i] * rl[u]; ss[u] += d * d; }
        if ((s & 7) == 7) asm volatile("" ::: "memory"); } }
#pragma unroll
    for (int u = 0; u < 2; ++u) { float x = ss[u]; x += __shfl_xor(x, 16); x += __shfl_xor(x, 32); ss[u] = 0.8f / sqrtf(x * (1.0f / 256.0f) + 1e-5f); }
    const int jj = lo_ & 15, gg = (lo_ >> 4) & 3;
    const float* gp = subg + 4 * gg;
    unsigned short* Yw = Yb + (long)((lo_ >> 6) * QBLK + jj) * 4096 + 4 * gg;
    { const __attribute__((address_space(1))) f32x4* sp = (const __attribute__((address_space(1))) f32x4*)Ob + lo_;
#pragma unroll
      for (int s = 0; s < 32; ++s) { const int u = s >> 4, dt = s & 15; const f32x4 a4 = *sp; sp += 512; asm volatile("" : "+v"(sp));
        const f32x4 g4 = *reinterpret_cast<const f32x4*>(gp + 16 * dt);
        float y[4];
#pragma unroll
        for (int i = 0; i < 4; ++i) y[i] = (a4[i] - o[u][dt][i] * rl[u]) * ss[u] * g4[i];
        uint2 w; w.x = cvtpk(y[0], y[1]); w.y = cvtpk(y[2], y[3]);
        *reinterpret_cast<uint2*>(Yw + (long)(16 * u) * 4096 + 16 * dt) = w;
        if ((s & 7) == 7) asm volatile("" ::: "memory"); } }
  }
#undef DMA
#undef BAR_AFTER
}
#undef MF16
}
namespace mk {
constexpr int NWAVES = 8, NTHR = NWAVES * 64;
constexpr int N_LAUNCHES = MK_N_LAUNCHES;
constexpr int PER_PHASE = 11;
constexpr int BATCH = 2, SEQ = 8192, DM = 4096, M = BATCH * SEQ, HYW = 2048, NIN = 12288, FFN = 11008, NGU = 2 * FFN, NMOD = 6 * DM, NHEAD = 8;
constexpr int QOFF = 3 * HYW, KOFF = QOFF + 2048, VOFF = KOFF + 2048;
constexpr int FFTN = 2 * SEQ;
constexpr float NORM_EPS = 1e-6f, SUBLN_EPS = 1e-5f, LAM_INIT = 0.2f;
constexpr size_t MiB = 1u << 20;
constexpr size_t WS_CTL = 0, CTL_ZERO_BYTES = 1 * MiB;
constexpr size_t WS_TW = 1 * MiB;
constexpr size_t WS_H3 = 2 * MiB;
constexpr size_t WS_ROPE = 4 * MiB;
constexpr size_t WS_WIN = 16 * MiB, WS_WOUT = 112 * MiB, WS_WGU = 144 * MiB, WS_WDN = 316 * MiB;
constexpr size_t WS_HA = 402 * MiB;
constexpr size_t WS_X0T = WS_HA, WS_YT = WS_HA + 64 * MiB;
constexpr size_t WS_PROJ = 530 * MiB;
constexpr size_t WS_ACT = WS_PROJ;
constexpr size_t WS_YMIX = 914 * MiB;
constexpr size_t WS_X1 = 1042 * MiB;
constexpr size_t WS_O0 = WS_X1, WS_O1 = WS_X1 + 128 * MiB;
constexpr size_t WS_KSPEC = 1298 * MiB;
constexpr size_t WS_KERN = 1170 * MiB;
constexpr size_t WS_VXT = 1330 * MiB;
constexpr size_t WS_X2 = 16 * MiB;
constexpr size_t WS_END = 1458 * MiB;
static_assert(WS_WIN + (size_t)NIN * DM * 2 <= WS_WOUT && WS_WOUT + (size_t)DM * DM * 2 <= WS_WGU && WS_WGU + (size_t)NGU * DM * 2 <= WS_WDN && WS_WDN + (size_t)DM * FFN * 2 <= WS_HA, "weights");
static_assert(WS_O0 + (size_t)M * 2048 * 4 <= WS_KERN && WS_KERN + (size_t)HYW * FFTN * 4 <= WS_KSPEC && WS_KSPEC + (size_t)256 * FFTN * 8 <= WS_VXT && WS_VXT + (size_t)HYW * 2 * SEQ * 4 <= WS_END && WS_X2 + (size_t)M * DM * 4 <= WS_WDN, "scratch");
static_assert(WS_HA + (size_t)M * DM * 2 <= WS_PROJ && WS_PROJ + (size_t)M * NIN * 2 <= WS_YMIX && WS_YMIX + (size_t)M * DM * 2 <= WS_X1 && WS_X1 + (size_t)M * DM * 4 <= WS_KSPEC, "activations");
constexpr int CW_TMO = 0, CW_CODE = 1, CW_LAM = 64;
constexpr int CW_XRANK = 1024;
constexpr int CW_BAR = 4096;
constexpr int CW_MOD = 16384;
static_assert((CW_MOD + 2 * NMOD) * 4 <= (int)CTL_ZERO_BYTES, "ctl");
constexpr int FFT_PHYS = FFTN + FFTN / 32;
constexpr int RING_BYTES = FFT_PHYS * 8;
constexpr int LDSCTL_OFF = RING_BYTES, MISC_OFF = LDSCTL_OFF + 320;
constexpr int LDS_BYTES = RING_BYTES + 1024;
static_assert(pg8::STAGE_BYTES <= RING_BYTES && att16::SHM_ATTN <= (size_t)RING_BYTES, "LDS map");

#define GAS __attribute__((address_space(1)))
#define LAS __attribute__((address_space(3)))
#define CAS __attribute__((address_space(4)))
typedef unsigned short bf16;
typedef unsigned v4u __attribute__((ext_vector_type(4)));
typedef unsigned v2u __attribute__((ext_vector_type(2)));
typedef float f32x4 __attribute__((ext_vector_type(4)));
typedef float f32x2 __attribute__((ext_vector_type(2)));
typedef float f32x8 __attribute__((ext_vector_type(8)));
typedef GAS unsigned gu32;
#define RLX_AGENT __ATOMIC_RELAXED, __HIP_MEMORY_SCOPE_AGENT
#define LDS_WAIT() asm volatile("s_waitcnt lgkmcnt(0)" ::: "memory")
#define VM_WAIT() asm volatile("s_waitcnt vmcnt(0)" ::: "memory")
__device__ __forceinline__ unsigned f2bf(float f) { unsigned u = __builtin_bit_cast(unsigned, f); return (u + 0x7fffu + ((u >> 16) & 1u)) >> 16; }
__device__ __forceinline__ unsigned pk2(float lo, float hi) { return f2bf(lo) | (f2bf(hi) << 16); }
__device__ __forceinline__ float bf2f(unsigned short b) { return __builtin_bit_cast(float, (unsigned)b << 16); }
__device__ __forceinline__ float bflo(unsigned w) { return __builtin_bit_cast(float, w << 16); }
__device__ __forceinline__ float bfhi(unsigned w) { return __builtin_bit_cast(float, w & 0xffff0000u); }

#define XB_TMO      128
#define XB_XCNT(j)  (256  + 64 * (j))
#define XB_XSUB(j)  (1280 + 64 * (j))
#define XB_XGEN(j)  (2304 + 64 * (j))
#define XB_TOP      3328
#define XB_TOPGEN   3392
#define XCD_BAR_WORDS 3456
#define XB_SPIN_CAP (1u << 18)

__device__ __forceinline__ unsigned xb_ld(unsigned* p)              { return __hip_atomic_load(p, __ATOMIC_RELAXED, __HIP_MEMORY_SCOPE_AGENT); }
__device__ __forceinline__ unsigned xb_add(unsigned* p, unsigned v) { return __hip_atomic_fetch_add(p, v, __ATOMIC_RELAXED, __HIP_MEMORY_SCOPE_AGENT); }
__device__ __forceinline__ unsigned xb_xcc_id() { return (unsigned)__builtin_amdgcn_s_getreg((3 << 11) | 20) & 0xFu; }
#define XB_SPIN(cond, bar) do { unsigned _sp = 0; while (cond) { __builtin_amdgcn_s_sleep(1); \
    if ((++_sp & 255u) == 0u) { if (xb_ld(&(bar)[XB_TMO])) break; if (_sp > XB_SPIN_CAP) { atomicAdd(&(bar)[XB_TMO], 1u); break; } } } } while (0)

struct XcdBarrier {
    unsigned* bar; unsigned x;
    volatile LAS unsigned* st;
};

__device__ __forceinline__ XcdBarrier xcd_barrier_post(unsigned* bar, volatile LAS unsigned* st) {
    XcdBarrier b; b.bar = bar; b.x = xb_xcc_id(); b.st = st;
    if (threadIdx.x == 0) (void)xb_add(&bar[XB_XCNT(b.x)], 1u);
    return b;
}
__device__ __forceinline__ void xcd_barrier_complete(unsigned* bar, unsigned x, unsigned& nloc, unsigned& nx) {
    const unsigned G = gridDim.x * gridDim.y * gridDim.z;
    unsigned sum, cnt, mine, sp = 0u;
    for (;;) {
        sum = 0u; cnt = 0u; mine = 0u;
#pragma unroll
        for (unsigned j = 0; j < 16; ++j) { const unsigned c = xb_ld(&bar[XB_XCNT(j)]); sum += c; cnt += (c > 0u) ? 1u : 0u; mine = (j == x) ? c : mine; }
        if (sum == G) break;
        __builtin_amdgcn_s_sleep(1);
        if ((++sp & 255u) == 0u) { if (xb_ld(&bar[XB_TMO])) break; if (sp > XB_SPIN_CAP) { atomicAdd(&bar[XB_TMO], 1u); break; } }
    }
    nloc = mine > 0u ? mine : 1u; nx = cnt > 0u ? cnt : 1u;
}

__device__ __forceinline__ void xcd_barrier(const XcdBarrier& b) {
    asm volatile("s_waitcnt vmcnt(0)" ::: "memory");
    __syncthreads();
    if (threadIdx.x == 0) {
        unsigned* bar = b.bar;
        __builtin_amdgcn_s_waitcnt(0);
        unsigned nloc = b.st[0], nx = b.st[1];
        if (nloc == 0u) { xcd_barrier_complete(bar, b.x, nloc, nx); b.st[0] = nloc; b.st[1] = nx; }
        const unsigned old = xb_add(&bar[XB_XSUB(b.x)], 1u);
        const unsigned gen = old / nloc;
        if (old + 1u == (gen + 1u) * nloc) {
            __builtin_amdgcn_fence(__ATOMIC_RELEASE, "agent");
            asm volatile("s_waitcnt vmcnt(0)" ::: "memory");
            const unsigned og = xb_add(&bar[XB_TOP], 1u);
            const unsigned tg = og / nx;
            if (og + 1u == (tg + 1u) * nx) xb_add(&bar[XB_TOPGEN], 1u);
            else XB_SPIN(xb_ld(&bar[XB_TOPGEN]) == tg, bar);
            __builtin_amdgcn_fence(__ATOMIC_ACQUIRE, "agent");
            xb_add(&bar[XB_XGEN(b.x)], 1u);
            asm volatile("s_waitcnt vmcnt(0)" ::: "memory");
        } else {
            XB_SPIN(xb_ld(&bar[XB_XGEN(b.x)]) == gen, bar);
            __builtin_amdgcn_fence(__ATOMIC_ACQUIRE, "agent");
            asm volatile("s_waitcnt vmcnt(0)" ::: "memory");
        }
    }
    __syncthreads();
}

__device__ __forceinline__ float wave_sum(float v) {
#pragma unroll
    for (int o = 1; o < 64; o <<= 1) v += __shfl_xor(v, o);
    return v;
}
__device__ __forceinline__ f32x2 cmul(f32x2 a, f32x2 b) { return (f32x2){a.x * b.x - a.y * b.y, a.x * b.y + a.y * b.x}; }
__device__ __forceinline__ f32x2 cmulc(f32x2 a, f32x2 b) { return (f32x2){a.x * b.x + a.y * b.y, a.y * b.x - a.x * b.y}; }

__device__ __forceinline__ void p0_transpose_item(const float* W, int N, int K, bf16* WT, int k0, int n0, int drow0, LAS float* scr, int lane) {
    f32x4 v[16];
    { const GAS f32x4* wp = (const GAS f32x4*)(W + (size_t)(k0 + (lane >> 4)) * N + n0 + 4 * (lane & 15));
#pragma unroll
      for (int i = 0; i < 16; ++i) { v[i] = *wp; wp += N; asm volatile("" : "+v"(wp)); } }
    __builtin_amdgcn_sched_barrier(0);
#pragma unroll
    for (int i = 0; i < 16; ++i) { const int kk = 4 * i + (lane >> 4); LAS float* d = scr + kk * 65 + 4 * (lane & 15); d[0] = v[i].x; d[1] = v[i].y; d[2] = v[i].z; d[3] = v[i].w; }
    LDS_WAIT(); asm volatile("" ::: "memory");
    const int c = lane & 7;
#pragma unroll
    for (int j = 0; j < 8; ++j) { const int n = (lane >> 3) + 8 * j; const LAS float* s = scr + (8 * c) * 65 + n;
        v4u o; o.x = pk2(s[0 * 65], s[1 * 65]); o.y = pk2(s[2 * 65], s[3 * 65]); o.z = pk2(s[4 * 65], s[5 * 65]); o.w = pk2(s[6 * 65], s[7 * 65]);
        *(GAS v4u*)(WT + (size_t)(drow0 + n) * K + k0 + 8 * c) = o; }
    LDS_WAIT(); asm volatile("" ::: "memory");
}
__device__ __forceinline__ void p0_weights(int gw, int NGW, int wave, int lane, LAS unsigned char* lds, const float* w_in, const float* w_out, const float* w_gate, const float* w_up,
                                           const float* w_down, bf16* WIN, bf16* WOUT, bf16* WGU, bf16* WDN) {
    LAS float* scr = (LAS float*)(lds + wave * 16640);
    constexpr int I_IN = (DM / 64) * (NIN / 64), I_OUT = (DM / 64) * (DM / 64), I_G = (DM / 64) * (FFN / 64), I_D = (FFN / 64) * (DM / 64);
    constexpr int NITEMS = I_IN + I_OUT + 2 * I_G + I_D;
    for (int it = gw; it < NITEMS; it += NGW) {
        int r = it;
        if (r < I_IN) { constexpr int nb = NIN / 64; const int kb = r / nb, n0 = (r % nb) * 64, blk = (n0 >> 6) & 3;
            const int dr = (n0 >= QOFF && n0 < VOFF) ? (blk == 1 ? n0 + 64 : (blk == 2 ? n0 - 64 : n0)) : n0;
            p0_transpose_item(w_in, NIN, DM, WIN, kb * 64, n0, dr, scr, lane); continue; } r -= I_IN;
        if (r < I_OUT) { constexpr int nb = DM / 64; const int kb = r / nb, n0 = (r % nb) * 64; p0_transpose_item(w_out, DM, DM, WOUT, kb * 64, n0, n0, scr, lane); continue; } r -= I_OUT;
        if (r < I_G) { constexpr int nb = FFN / 64; const int kb = r / nb, n0 = (r % nb) * 64; p0_transpose_item(w_gate, FFN, DM, WGU, kb * 64, n0, 256 * (n0 >> 7) + (n0 & 127), scr, lane); continue; } r -= I_G;
        if (r < I_G) { constexpr int nb = FFN / 64; const int kb = r / nb, n0 = (r % nb) * 64; p0_transpose_item(w_up, FFN, DM, WGU, kb * 64, n0, 256 * (n0 >> 7) + 128 + (n0 & 127), scr, lane); continue; } r -= I_G;
        { constexpr int nb = DM / 64; const int kb = r / nb, n0 = (r % nb) * 64; p0_transpose_item(w_down, DM, FFN, WDN, kb * 64, n0, n0, scr, lane); }
    }
}
__device__ __forceinline__ void p0_adaln(int gw, int NGW, int lane, const float* c, const float* w_ada, const float* b_ada, float* mod) {
    for (int it = gw; it < 64 * 96; it += NGW) {
        const int kc = it / 96, nc = it % 96, k0 = kc * 64, n0 = nc * 256 + 4 * lane;
        float cv0 = c[k0 + lane], cv1 = c[DM + k0 + lane];
        cv0 = cv0 / (1.0f + expf(-cv0)); cv1 = cv1 / (1.0f + expf(-cv1));
        f32x4 a0 = {0.f, 0.f, 0.f, 0.f}, a1 = {0.f, 0.f, 0.f, 0.f};
        const GAS f32x4* wp = (const GAS f32x4*)(w_ada + (size_t)k0 * NMOD + n0);
#pragma unroll 8
        for (int k = 0; k < 64; ++k) { const f32x4 w = wp[(size_t)k * (NMOD / 4)]; const float s0 = __shfl(cv0, k), s1 = __shfl(cv1, k); a0 += s0 * w; a1 += s1 * w; }
        if (kc == 0) { const f32x4 bv = *(const GAS f32x4*)(b_ada + n0); a0 += bv; a1 += bv; }
        float* m0 = mod + n0; float* m1 = mod + NMOD + n0;
        unsafeAtomicAdd(m0 + 0, a0.x); unsafeAtomicAdd(m0 + 1, a0.y); unsafeAtomicAdd(m0 + 2, a0.z); unsafeAtomicAdd(m0 + 3, a0.w);
        unsafeAtomicAdd(m1 + 0, a1.x); unsafeAtomicAdd(m1 + 1, a1.y); unsafeAtomicAdd(m1 + 2, a1.z); unsafeAtomicAdd(m1 + 3, a1.w);
    }
}
__device__ __forceinline__ void p0_filter_mlp(int gw, int NGW, int lane, const float* w1, const float* b1, const float* w2, const float* b2, const float* w3, const float* b3,
                                              const float* freq, float* h3) {
    const float fr = freq[lane], bb1 = b1[lane], bb2 = b2[lane], bb3 = b3[lane];
    for (int i = gw; i < SEQ; i += NGW) {
        const float ti = (float)i * (1.0f / (float)(SEQ - 1));
        const float wi = (6.283185307179586f * (float)i) / (float)SEQ;
        const int kf = (lane >= 17) ? lane - 17 : lane - 1;
        const float fk = 1e-4f + (float)(kf & 15) * ((15.0f - 1e-4f) / 15.0f), a = fk * wi;
        const float z = (lane == 0) ? ti : ((lane <= 16) ? cosf(a) : -sinf(a));
        float acc = bb1;
        for (int l = 0; l < 33; ++l) acc += __shfl(z, l) * w1[l * 64 + lane];
        float h = sinf(fr * acc);
        acc = bb2;
        for (int l = 0; l < 64; ++l) acc += __shfl(h, l) * w2[l * 64 + lane];
        h = sinf(fr * acc);
        acc = bb3;
        for (int l = 0; l < 64; ++l) acc += __shfl(h, l) * w3[l * 64 + lane];
        h = sinf(fr * acc);
        h3[(size_t)i * 64 + lane] = h;
    }
}
__device__ __forceinline__ void p0_tables(int gt, int NGT, const int* pos, f32x2* rope, f32x2* tw) {
    for (int idx = gt; idx < M * 64; idx += NGT) { const int m = idx >> 6, i = idx & 63;
        const float inv = 1.0f / powf(10000.0f, (float)(2 * i) * (1.0f / 128.0f)); const float ang = (float)pos[m] * inv;
        rope[idx] = (f32x2){cosf(ang), sinf(ang)}; }
    for (int p = gt; p < FFTN; p += NGT) { const float a = (float)p * (1.0f / (float)SEQ); tw[p] = (f32x2){cospif(a), -sinpif(a)}; }
}

#define ROWS_SBAR() __builtin_amdgcn_sched_barrier(0)
__device__ __forceinline__ void rms_mod_table(int tid, LAS unsigned char* lds, const float* g, const float* mod, int sh_off, int sc_off) {
    LAS float* La = (LAS float*)lds; LAS float* Ls = La + BATCH * DM;
    for (int i = tid; i < BATCH * DM; i += NTHR) { const int b = i / DM, col = i % DM; La[i] = g[col] * (1.0f + mod[(size_t)b * NMOD + sc_off + col]); Ls[i] = mod[(size_t)b * NMOD + sh_off + col]; }
}
__device__ __forceinline__ void rms_mod_rows(int gw, int NGW, int lane, LAS unsigned char* lds, const float* X, bf16* out) {
    LAS float* La = (LAS float*)lds; LAS float* Ls = La + BATCH * DM;
    for (int m = gw; m < M; m += NGW) {
        const GAS f32x4* xr = (const GAS f32x4*)(X + (size_t)m * DM) + lane;
        f32x4 v[16];
#pragma unroll
        for (int j = 0; j < 16; ++j) v[j] = xr[64 * j];
        ROWS_SBAR();
        float s = 0.f;
#pragma unroll
        for (int j = 0; j < 16; ++j) s += (v[j].x * v[j].x + v[j].y * v[j].y) + (v[j].z * v[j].z + v[j].w * v[j].w);
        const float rstd = 1.0f / sqrtf(wave_sum(s) * (1.f / DM) + NORM_EPS);
        const LAS f32x4* a = (const LAS f32x4*)(La + (m / SEQ) * DM) + lane; const LAS f32x4* sh = (const LAS f32x4*)(Ls + (m / SEQ) * DM) + lane;
        GAS v2u* o = (GAS v2u*)(out + (size_t)m * DM) + lane;
#pragma unroll
        for (int j = 0; j < 16; ++j) { const f32x4 y = (v[j] * rstd) * a[64 * j] + sh[64 * j]; o[64 * j] = (v2u){pk2(y.x, y.y), pk2(y.z, y.w)}; }
    }
}
__device__ __forceinline__ void rms_mod_rows_b16(int gw, int NGW, int lane, LAS unsigned char* lds, const bf16* X, bf16* out) {
    LAS float* La = (LAS float*)lds; LAS float* Ls = La + BATCH * DM;
    for (int m = gw; m < M; m += NGW) {
        const GAS v4u* xr = (const GAS v4u*)(X + (size_t)m * DM) + lane;
        v4u v[8];
#pragma unroll
        for (int j = 0; j < 8; ++j) v[j] = xr[64 * j];
        ROWS_SBAR();
        float s = 0.f;
#pragma unroll
        for (int j = 0; j < 8; ++j) {
#pragma unroll
            for (int q = 0; q < 4; ++q) { const float lo = bflo(v[j][q]), hi = bfhi(v[j][q]); s += lo * lo + hi * hi; } }
        const float rstd = 1.0f / sqrtf(wave_sum(s) * (1.f / DM) + NORM_EPS);
        const LAS f32x4* a = (const LAS f32x4*)(La + (m / SEQ) * DM) + 2 * lane; const LAS f32x4* sh = (const LAS f32x4*)(Ls + (m / SEQ) * DM) + 2 * lane;
        GAS v4u* o = (GAS v4u*)(out + (size_t)m * DM) + lane;
#pragma unroll
        for (int j = 0; j < 8; ++j) { const f32x4 a0 = a[128 * j], a1 = a[128 * j + 1], s0 = sh[128 * j], s1 = sh[128 * j + 1];
            const f32x4 x0 = (f32x4){bflo(v[j].x), bfhi(v[j].x), bflo(v[j].y), bfhi(v[j].y)}, x1 = (f32x4){bflo(v[j].z), bfhi(v[j].z), bflo(v[j].w), bfhi(v[j].w)};
            const f32x4 y0 = (x0 * rstd) * a0 + s0, y1 = (x1 * rstd) * a1 + s1;
            o[64 * j] = (v4u){pk2(y0.x, y0.y), pk2(y0.z, y0.w), pk2(y1.x, y1.y), pk2(y1.z, y1.w)}; }
    }
}
__device__ __forceinline__ void rms_final_rows_b16(int gw, int NGW, int lane, const bf16* X, float* out, const float* g) {
    f32x4 gg[16];
#pragma unroll
    for (int j = 0; j < 8; ++j) { gg[2 * j] = *(const GAS f32x4*)(g + 8 * lane + 512 * j); gg[2 * j + 1] = *(const GAS f32x4*)(g + 8 * lane + 512 * j + 4); }
    for (int m = gw; m < M; m += 2 * NGW) {
        const int m2 = m + NGW; const bool two = m2 < M;
        const GAS v4u* xr = (const GAS v4u*)(X + (size_t)m * DM) + lane; const GAS v4u* xr2 = (const GAS v4u*)(X + (size_t)(two ? m2 : m) * DM) + lane;
        v4u v[8], w[8];
#pragma unroll
        for (int j = 0; j < 8; ++j) v[j] = xr[64 * j];
#pragma unroll
        for (int j = 0; j < 8; ++j) w[j] = xr2[64 * j];
        ROWS_SBAR();
#pragma unroll
        for (int rr = 0; rr < 2; ++rr) {
            float s = 0.f;
#pragma unroll
            for (int j = 0; j < 8; ++j) {
#pragma unroll
                for (int q = 0; q < 4; ++q) { const unsigned u = rr ? w[j][q] : v[j][q]; const float lo = bflo(u), hi = bfhi(u); s += lo * lo + hi * hi; } }
            const float rstd = 1.0f / sqrtf(wave_sum(s) * (1.f / DM) + NORM_EPS);
            if (rr == 0 || two) { GAS f32x4* orow = (GAS f32x4*)(out + (size_t)(rr ? m2 : m) * DM) + 2 * lane;
#pragma unroll
                for (int j = 0; j < 8; ++j) { const v4u u = rr ? w[j] : v[j];
                    orow[128 * j] = ((f32x4){bflo(u.x), bfhi(u.x), bflo(u.y), bfhi(u.y)} * rstd) * gg[2 * j];
                    orow[128 * j + 1] = ((f32x4){bflo(u.z), bfhi(u.z), bflo(u.w), bfhi(u.w)} * rstd) * gg[2 * j + 1]; } }
        }
    }
}
__device__ __forceinline__ void rms_final_rows(int gw, int NGW, int lane, const float* X, float* out, const float* g) {
    f32x4 gg[16];
#pragma unroll
    for (int j = 0; j < 16; ++j) gg[j] = *(const GAS f32x4*)(g + 4 * lane + 256 * j);
    for (int m = gw; m < M; m += 2 * NGW) {
        const int m2 = m + NGW; const bool two = m2 < M;
        const GAS f32x4* xr = (const GAS f32x4*)(X + (size_t)m * DM) + lane; const GAS f32x4* xr2 = (const GAS f32x4*)(X + (size_t)(two ? m2 : m) * DM) + lane;
        f32x4 v[16], w[16];
#pragma unroll
        for (int j = 0; j < 16; ++j) v[j] = xr[64 * j];
#pragma unroll
        for (int j = 0; j < 16; ++j) w[j] = xr2[64 * j];
        ROWS_SBAR();
        float s = 0.f, s2 = 0.f;
#pragma unroll
        for (int j = 0; j < 16; ++j) s += (v[j].x * v[j].x + v[j].y * v[j].y) + (v[j].z * v[j].z + v[j].w * v[j].w);
        const float rstd = 1.0f / sqrtf(wave_sum(s) * (1.f / DM) + NORM_EPS);
        GAS f32x4* orow = (GAS f32x4*)(out + (size_t)m * DM) + lane;
#pragma unroll
        for (int j = 0; j < 16; ++j) orow[64 * j] = (v[j] * rstd) * gg[j];
#pragma unroll
        for (int j = 0; j < 16; ++j) s2 += (w[j].x * w[j].x + w[j].y * w[j].y) + (w[j].z * w[j].z + w[j].w * w[j].w);
        const float rstd2 = 1.0f / sqrtf(wave_sum(s2) * (1.f / DM) + NORM_EPS);
        if (two) { GAS f32x4* orow2 = (GAS f32x4*)(out + (size_t)m2 * DM) + lane;
#pragma unroll
            for (int j = 0; j < 16; ++j) orow2[64 * j] = (w[j] * rstd2) * gg[j]; }
    }
}
constexpr float HY_MIND = -3.0701134573253946f, HY_MAXD = -15.350567286626973f, HY_DSTEP = (HY_MAXD - HY_MIND) / (float)(HYW - 1);
typedef float f32x16 __attribute__((ext_vector_type(16)));
__device__ __forceinline__ void p1_kern(int gw, int NGW, int lane, const float* h3, const float* w4, float* kern) {
    const int l32 = lane & 31, hi = lane >> 5;
    for (int it = gw; it < (SEQ / 32) * 8; it += NGW) {
        const int tb = it >> 3, cg = it & 7, t = tb * 32 + l32;
        float hb[32];
#pragma unroll
        for (int q = 0; q < 8; ++q) { const f32x4 v = *(const GAS f32x4*)(h3 + (size_t)t * 64 + 32 * hi + 4 * q); hb[4 * q] = v.x; hb[4 * q + 1] = v.y; hb[4 * q + 2] = v.z; hb[4 * q + 3] = v.w; }
        const float tn = (float)t * (1.0f / (float)(SEQ - 1));
#pragma unroll 1
        for (int cb = 0; cb < 16; ++cb) {
            const int c0 = cg * 512 + cb * 32;
            float wa[32];
            { const GAS float* wp = (const GAS float*)w4 + (size_t)(32 * hi) * (2 * HYW) + c0 + l32;
#pragma unroll
              for (int sI = 0; sI < 32; ++sI) { wa[sI] = *wp; wp += 2 * HYW; asm volatile("" : "+v"(wp)); } }
            f32x16 d = {};
#pragma unroll
            for (int sI = 0; sI < 32; ++sI) d = __builtin_amdgcn_mfma_f32_32x32x2f32(wa[sI], hb[sI], d, 0, 0, 0);
            const bool fwd = c0 < HYW; const int cbase = (c0 & (HYW - 1)) + 4 * hi;
            const int idx = fwd ? t : ((t == 0) ? SEQ : FFTN - t);
            GAS float* kp = (GAS float*)kern + (size_t)cbase * FFTN + idx;
#pragma unroll
            for (int r = 0; r < 16; ++r) { const int c = cbase + (r & 3) + 8 * (r >> 2);
                const float delta = fabsf(HY_MIND + (float)c * HY_DSTEP); float val = d[r] * expf(-tn * delta);
                if (!fwd && t == 0) val = 0.f;
                *kp = val; kp += ((r & 3) == 3 ? 5 : 1) * FFTN; asm volatile("" : "+v"(kp)); }
        }
    }
}
__device__ __forceinline__ void p3_rope(int gw, int NGW, int lane, bf16* proj, const f32x2* rope) {
    const int mp = lane >> 3, dc = lane & 7;
    for (int m = gw; m < M; m += NGW) {
        f32x4 cs[4];
#pragma unroll
        for (int i = 0; i < 4; ++i) cs[i] = *(const GAS f32x4*)((const float*)(rope + (size_t)m * 64 + 8 * dc) + 4 * i);
#pragma unroll
        for (int it = 0; it < 4; ++it) {
            bf16* p = proj + (size_t)m * NIN + QOFF + (it * 8 + mp) * 128 + 8 * dc;
            const v4u a = *(const GAS v4u*)p, b = *(const GAS v4u*)(p + 64); v4u oa, ob;
#pragma unroll
            for (int w = 0; w < 4; ++w) {
                const float x1l = bflo(a[w]), x1h = bfhi(a[w]), x2l = bflo(b[w]), x2h = bfhi(b[w]);
                const float cl = cs[w].x, sl = cs[w].y, ch = cs[w].z, sh = cs[w].w;
                oa[w] = pk2(x1l * cl - x2l * sl, x1h * ch - x2h * sh); ob[w] = pk2(x2l * cl + x1l * sl, x2h * ch + x1h * sh); }
            *(GAS v4u*)p = oa; *(GAS v4u*)(p + 64) = ob;
        }
    }
}
__device__ __forceinline__ void p3_hyena_pre(int vcu, int G, int tid, LAS unsigned char* lds, const bf16* proj, const float* conv_w, const float* conv_b, float* vxT, bf16* x0T) {
    constexpr int CT = 128, PIT = CT + 2;
    LAS unsigned short* s = (LAS unsigned short*)lds;
    const int wave = tid >> 6, lane = tid & 63;
    constexpr int NIT = (M / 64) * (HYW / CT), NCH = 3 * 66 * (CT / 8), NLD = (NCH + NTHR - 1) / NTHR;
    v4u R[NLD];
#define HP_LOAD(item) do { const int mt_ = (item) / (HYW / CT), ct_ = (item) % (HYW / CT), m0_ = mt_ * 64, b_ = m0_ / SEQ, t0_ = m0_ % SEQ, c0_ = ct_ * CT; \
        _Pragma("unroll") for (int i_ = 0; i_ < NLD; ++i_) { const int ch_ = tid + NTHR * i_; R[i_] = (v4u){0u, 0u, 0u, 0u}; \
            if (ch_ < NCH) { const int g_ = ch_ / (66 * (CT / 8)), rem_ = ch_ % (66 * (CT / 8)), tt_ = rem_ / (CT / 8), k8_ = rem_ % (CT / 8), t_ = t0_ + tt_ - 1; \
                if (t_ >= 0 && t_ < SEQ) R[i_] = *(const GAS v4u*)(proj + (size_t)(b_ * SEQ + t_) * NIN + g_ * HYW + c0_ + 8 * k8_); } } } while (0)
    int it = vcu;
    if (it < NIT) HP_LOAD(it);
    for (; it < NIT; it += G) {
        const int mt = it / (HYW / CT), ct = it % (HYW / CT), m0 = mt * 64, b = m0 / SEQ, t0 = m0 % SEQ, c0 = ct * CT;
        __syncthreads();
#pragma unroll
        for (int i = 0; i < NLD; ++i) { const int ch = tid + NTHR * i;
            if (ch < NCH) { const int g = ch / (66 * (CT / 8)), rem = ch % (66 * (CT / 8)), tt = rem / (CT / 8), k8 = rem % (CT / 8);
                LAS unsigned* d = (LAS unsigned*)(s + (g * 66 + tt) * PIT + 8 * k8); d[0] = R[i].x; d[1] = R[i].y; d[2] = R[i].z; d[3] = R[i].w; } }
        __syncthreads();
        if (it + G < NIT) HP_LOAD(it + G);
#pragma unroll 4
        for (int q = 0; q < CT / 8; ++q) {
            const int cc = wave * (CT / 8) + q, c = c0 + cc; float r[3];
#pragma unroll
            for (int g = 0; g < 3; ++g) { const int ch = g * HYW + c; const float w0 = conv_w[ch], w1 = conv_w[3 * HYW + ch], w2 = conv_w[6 * HYW + ch], bb = conv_b[ch];
                const LAS unsigned short* sp = s + (g * 66 + lane) * PIT + cc;
                r[g] = ((bb + bf2f(sp[0]) * w0) + bf2f(sp[PIT]) * w1) + bf2f(sp[2 * PIT]) * w2; }
            const size_t o = ((size_t)c * 2 + b) * SEQ + t0 + lane;
            vxT[o] = r[2] * r[1]; x0T[o] = (bf16)f2bf(r[0]);
        }
    }
#undef HP_LOAD
}
constexpr float kC32[16] = {1.0f, 0.98078528040323043f, 0.92387953251128674f, 0.83146961230254524f, 0.70710678118654752f, 0.55557023301960218f, 0.38268343236508977f, 0.19509032201612825f,
                            0.0f, -0.19509032201612825f, -0.38268343236508977f, -0.55557023301960218f, -0.70710678118654752f, -0.83146961230254524f, -0.92387953251128674f, -0.98078528040323043f};
constexpr float kS32[16] = {0.0f, 0.19509032201612825f, 0.38268343236508977f, 0.55557023301960218f, 0.70710678118654752f, 0.83146961230254524f, 0.92387953251128674f, 0.98078528040323043f,
                            1.0f, 0.98078528040323043f, 0.92387953251128674f, 0.83146961230254524f, 0.70710678118654752f, 0.55557023301960218f, 0.38268343236508977f, 0.19509032201612825f};
__host__ __device__ constexpr int brev(int r, int bits) { int o = 0; for (int i = 0; i < bits; ++i) o = (o << 1) | ((r >> i) & 1); return o; }
template <int A, int N, int LO, int SG, int I> struct Bf {
    static __device__ __forceinline__ void run(f32x2 (&x)[A]) {
        if constexpr (I < N / 2) {
            constexpr int H = N / 2, ti = I * (32 / N);
            constexpr float c = kC32[ti], s = (float)SG * kS32[ti];
            const f32x2 a = x[LO + I], b = x[LO + I + H], d = a - b;
            x[LO + I] = a + b;
            if constexpr (ti == 0) x[LO + I + H] = d;
            else if constexpr (ti == 8) x[LO + I + H] = (f32x2){-s * d.y, s * d.x};
            else x[LO + I + H] = (f32x2){d.x * c - d.y * s, d.x * s + d.y * c};
            Bf<A, N, LO, SG, I + 1>::run(x);
        }
    }
};
template <int A, int N, int LO, int SG> __device__ __forceinline__ void dif(f32x2 (&x)[A]) {
    if constexpr (N >= 2) { Bf<A, N, LO, SG, 0>::run(x); dif<A, N / 2, LO, SG>(x); dif<A, N / 2, LO + N / 2, SG>(x); }
}
__device__ __forceinline__ f32x2 twid(int p) { const float a = (float)p * (1.0f / (float)FFTN); return (f32x2){__builtin_amdgcn_cosf(a), -__builtin_amdgcn_sinf(a)}; }
__device__ __forceinline__ void fft_p1_fwd_one(int j, f32x2 (&x)[16], LAS f32x2* L) {
    dif<16, 16, 0, -1>(x);
    LAS f32x2* p = L + j + (j >> 5);
    int jo = j; asm volatile("" : "+v"(jo));
    { const f32x2 w1 = twid(jo); f32x2 w = w1;
      p[0] = x[0];
#pragma unroll
      for (int m = 1; m < 16; ++m) { p[1056 * m] = cmul(x[brev(m, 4)], w); if (m < 15) w = cmul(w, w1); } }
}
template <int SG> __device__ __forceinline__ void fft_p2(int tid, LAS f32x2* L, const GAS f32x2* T) {
    const int B = tid >> 5, j = tid & 31; LAS f32x2* p = L + B * 1056 + j;
    int jo = 16 * j; asm volatile("" : "+v"(jo));
    f32x2 x[32];
#pragma unroll
    for (int k = 0; k < 32; ++k) { f32x2 v = p[33 * k]; if (SG > 0 && k != 0) v = cmulc(v, twid(jo * k)); x[k] = v; }
    dif<32, 32, 0, SG>(x);
#pragma unroll
    for (int r = 0; r < 32; ++r) { const int m = brev(r, 5); f32x2 v = x[r]; if (SG < 0 && m != 0) v = cmul(v, twid(jo * m)); p[33 * m] = v; }
}
#define FFT_WSYNC() do { asm volatile("s_waitcnt lgkmcnt(0)" ::: "memory"); } while (0)
__device__ __forceinline__ void p4_fft(int vcu, int G, int tid, LAS unsigned char* lds, const float* kern, const float* vxT, const bf16* x0T, const float* hbias, bf16* yT, f32x2* kspec) {
    LAS f32x2* L = (LAS f32x2*)lds;
    LAS f32x2* p3 = L + 33 * tid;
    GAS f32x2* ks = (GAS f32x2*)kspec + tid;
    float ka[16], kb[16];
    int c = vcu;
    if (c < HYW) { const GAS float* kp = (const GAS float*)(kern + (size_t)c * FFTN) + tid;
#pragma unroll
        for (int k = 0; k < 16; ++k) { ka[k] = kp[0]; kb[k] = kp[512]; kp += 1024; asm volatile("" : "+v"(kp)); } }
    for (; c < HYW; c += G) {
        const float* v0 = vxT + (size_t)c * 2 * SEQ; const float* v1 = v0 + SEQ;
        f32x2 da[16], db[16];
        { const GAS float* vp = (const GAS float*)v0 + tid;
#pragma unroll
          for (int k = 0; k < 8; ++k) { da[k] = (f32x2){vp[0], vp[SEQ]}; db[k] = (f32x2){vp[512], vp[SEQ + 512]}; vp += 1024; asm volatile("" : "+v"(vp)); } }
#pragma unroll
        for (int k = 8; k < 16; ++k) { da[k] = (f32x2){0.f, 0.f}; db[k] = (f32x2){0.f, 0.f}; }
        { f32x2 x[16];
#pragma unroll
          for (int k = 0; k < 16; ++k) x[k] = (f32x2){ka[k], 0.f};
          fft_p1_fwd_one(tid, x, L);
#pragma unroll
          for (int k = 0; k < 16; ++k) x[k] = (f32x2){kb[k], 0.f};
          fft_p1_fwd_one(tid + 512, x, L); }
        __syncthreads();
        fft_p2<-1>(tid, L, nullptr);
        FFT_WSYNC();
        {
            f32x2 Kr[32];
#pragma unroll
            for (int i = 0; i < 32; ++i) Kr[i] = p3[i];
            dif<32, 32, 0, -1>(Kr);
            GAS f32x2* kp = ks;
#pragma unroll
            for (int i = 0; i < 32; ++i) { *kp = Kr[i] * (1.0f / (float)FFTN); kp += 512; asm volatile("" : "+v"(kp)); }
        }
        __syncthreads();
        fft_p1_fwd_one(tid, da, L); fft_p1_fwd_one(tid + 512, db, L);
        __syncthreads();
        fft_p2<-1>(tid, L, nullptr);
        FFT_WSYNC();
        {
            f32x2 x[32], y[32];
#pragma unroll
            for (int i = 0; i < 32; ++i) x[i] = p3[i];
            dif<32, 32, 0, -1>(x);
            const GAS f32x2* kp = ks;
#pragma unroll
            for (int r = 0; r < 32; ++r) { x[r] = cmul(x[r], *kp); kp += 512; asm volatile("" : "+v"(kp)); }
#pragma unroll
            for (int m = 0; m < 32; ++m) y[m] = x[brev(m, 5)];
            dif<32, 32, 0, 1>(y);
#pragma unroll
            for (int r = 0; r < 32; ++r) p3[brev(r, 5)] = y[r];
        }
        FFT_WSYNC();
        if (c + G < HYW) { const GAS float* kp = (const GAS float*)(kern + (size_t)(c + G) * FFTN) + tid;
#pragma unroll
            for (int k = 0; k < 16; ++k) { ka[k] = kp[0]; kb[k] = kp[512]; kp += 1024; asm volatile("" : "+v"(kp)); } }
        fft_p2<1>(tid, L, nullptr);
        __syncthreads();
        const float hb = hbias[c];
        const bf16* x0p = x0T + (size_t)c * 2 * SEQ; bf16* yp = yT + (size_t)c * 2 * SEQ;
#pragma unroll 1
        for (int jj = 0; jj < 2; ++jj) { const int j = tid + 512 * jj;
            f32x2 x[16]; LAS f32x2* p = L + j + (j >> 5);
            int jo = j; asm volatile("" : "+v"(jo));
            { const f32x2 w1 = twid(jo); f32x2 w = w1;
#pragma unroll
              for (int m = 0; m < 16; ++m) { f32x2 v = p[1056 * m]; if (m != 0) { v = cmulc(v, w); if (m < 15) w = cmul(w, w1); } x[m] = v; } }
            dif<16, 16, 0, 1>(x);
#pragma unroll
            for (int r = 0; r < 16; ++r) { const int k = brev(r, 4);
                if (k < 8) { const int t = j + 1024 * k;
                    const float y0 = (x[r].x + v0[t] * hb) * bf2f(x0p[t]), y1 = (x[r].y + v1[t] * hb) * bf2f(x0p[SEQ + t]);
                    yp[t] = (bf16)f2bf(y0); yp[SEQ + t] = (bf16)f2bf(y1); } }
        }
        __syncthreads();
    }
}
__device__ __forceinline__ void attn_unit(int P, char* lds, const bf16* proj, float* O0, bf16* ymix, const float* lamp, const float* subg) {
    const int qb = P & 31, h = (P >> 5) & 7, b = P >> 8;
    const att9::bf16* Pj = (const att9::bf16*)proj;
    const size_t row0 = (size_t)(b * SEQ + qb * 256);
    const att9::bf16* Vh = Pj + (size_t)(b * SEQ) * NIN + VOFF + h * 256;
    float* Ob = O0 + ((size_t)((P / (int)gridDim.x) & 1) * gridDim.x + blockIdx.x) * (NTHR * 128);
    unsigned short* Yb = ymix + row0 * DM + HYW + h * 256;
#pragma unroll 1
    for (int j = 0; j < 2; ++j) {
        const float lam = *lamp;
        int seq = SEQ; asm volatile("" : "+s"(seq));
        att16::attn_body(j, Pj + row0 * NIN + QOFF + h * 256 + j * 128, Pj + (size_t)(b * SEQ) * NIN + KOFF + h * 256 + j * 128, Vh, Ob, Yb, lam, subg, seq, lds);
        __syncthreads();
    }
}
__device__ __forceinline__ void p5_hyena_post(int vcu, int G, int tid, LAS unsigned char* lds, const bf16* yT, bf16* ymix) {
    LAS unsigned short* s = (LAS unsigned short*)lds;
    constexpr int NIT = (M / 64) * (HYW / 64);
    const int c = tid >> 3, k8 = tid & 7;
#define POST_LOAD(item) (*(const GAS v4u*)(yT + ((size_t)(((item) & 31) * 64 + c) * 2 + (((item) >> 5) * 64) / SEQ) * SEQ + (((item) >> 5) * 64) % SEQ + 8 * k8))
    int it = vcu; v4u v = {0u, 0u, 0u, 0u};
    if (it < NIT) v = POST_LOAD(it);
    for (; it < NIT; it += G) {
        const int mt = it >> 5, ct = it & 31, m0 = mt * 64, c0 = ct * 64;
        __syncthreads();
        { LAS unsigned* d = (LAS unsigned*)(s + c * 66 + 8 * k8); d[0] = v.x; d[1] = v.y; d[2] = v.z; d[3] = v.w; }
        __syncthreads();
        if (it + G < NIT) v = POST_LOAD(it + G);
        { const int t = tid >> 3; const LAS unsigned short* sp = s + (8 * k8) * 66 + t; v4u o;
          o.x = (unsigned)sp[0 * 66] | ((unsigned)sp[1 * 66] << 16); o.y = (unsigned)sp[2 * 66] | ((unsigned)sp[3 * 66] << 16);
          o.z = (unsigned)sp[4 * 66] | ((unsigned)sp[5 * 66] << 16); o.w = (unsigned)sp[6 * 66] | ((unsigned)sp[7 * 66] << 16);
          *(GAS v4u*)(ymix + (size_t)(m0 + t) * DM + c0 + 8 * k8) = o; }
    }
#undef POST_LOAD
}
struct Args { const void* in[29]; float* out; unsigned char* ws; int ph_lo, ph_hi; };
static_assert(sizeof(Args) == 256, "Args has no padding bytes");
enum { I_X = 0, I_C, I_POS, I_WADA, I_BADA, I_GMIX, I_GFFN, I_WIN, I_CONVW, I_CONVB, I_FW1, I_FB1, I_FW2, I_FB2, I_FW3, I_FB3, I_FW4, I_FFREQ, I_HBIAS,
       I_LQ1, I_LK1, I_LQ2, I_LK2, I_SUBG, I_WOUT, I_WGATE, I_WUP, I_WDOWN, I_GFINAL };
__global__ void __launch_bounds__(NTHR, 2) mega_fwd(Args args) {
    extern __shared__ __attribute__((aligned(16))) unsigned char lds[];
    LAS unsigned char* const L = (LAS unsigned char*)lds;
    volatile LAS unsigned* const MISC = (volatile LAS unsigned*)(L + MISC_OFF);
    const int tid = threadIdx.x, lane = tid & 63, wave = __builtin_amdgcn_readfirstlane(tid >> 6);
    const int G = gridDim.x, bx = blockIdx.x, NGW = G * NWAVES, NGT = G * NTHR;
    int vcu = (G % 8 == 0) ? (bx % 8) * (G / 8) + bx / 8 : bx, cid = bx;
    int gw = vcu * NWAVES + wave, gt = vcu * NTHR + tid;
    unsigned char* const ws = args.ws;
    gu32* const ctl = (gu32*)(ws + WS_CTL);
#define INF(k) ((const float*)args.in[k])
    float* const mod = (float*)(ws + WS_CTL) + CW_MOD;
    f32x2* const tw = (f32x2*)(ws + WS_TW); float* const h3 = (float*)(ws + WS_H3); f32x2* const rope = (f32x2*)(ws + WS_ROPE);
    bf16* const WIN = (bf16*)(ws + WS_WIN); bf16* const WOUT = (bf16*)(ws + WS_WOUT); bf16* const WGU = (bf16*)(ws + WS_WGU); bf16* const WDN = (bf16*)(ws + WS_WDN);
    bf16* const HA = (bf16*)(ws + WS_HA); bf16* const X0T = (bf16*)(ws + WS_X0T); bf16* const YT = (bf16*)(ws + WS_YT);
    bf16* const PROJ = (bf16*)(ws + WS_PROJ); bf16* const ACT = (bf16*)(ws + WS_ACT); bf16* const YMIX = (bf16*)(ws + WS_YMIX);
    bf16* const X1 = (bf16*)(ws + WS_X1); float* const O0 = (float*)(ws + WS_O0);
    float* const KERN = (float*)(ws + WS_KERN); float* const VXT = (float*)(ws + WS_VXT); bf16* const X2 = (bf16*)(ws + WS_X2);

    for (int u = tid; u < (LDS_BYTES - LDSCTL_OFF) / 4; u += NTHR) ((LAS unsigned*)(L + LDSCTL_OFF))[u] = 0u;
    __syncthreads();
    XcdBarrier bar; bar.bar = (unsigned*)(ctl + CW_BAR); bar.x = 0; bar.st = nullptr;
    if (N_LAUNCHES != PER_PHASE) bar = xcd_barrier_post((unsigned*)(ctl + CW_BAR), MISC + 8);
    const unsigned my_xcc = (unsigned)__builtin_amdgcn_readfirstlane((int)(xb_xcc_id() & 7u));
    if (N_LAUNCHES != PER_PHASE && tid == 0) MISC[16] = __hip_atomic_fetch_add((unsigned*)(ctl + CW_XRANK + 64 * my_xcc), 1u, RLX_AGENT);
#define GRID_BAR(seam) do { if (N_LAUNCHES == PER_PHASE) { if (tid == 0) __hip_atomic_store(ctl + CW_TMO, 0xBADBA0u | (unsigned)(seam), RLX_AGENT); } else { xcd_barrier(bar); } } while (0)
    const int lo = args.ph_lo, hi = args.ph_hi;
#define IN(k) (lo <= (k) && (k) < hi)
#define BOTH(k) (IN(k) && IN((k) + 1))

    if (IN(0)) {
        p0_adaln(gw, NGW, lane, INF(I_C), INF(I_WADA), INF(I_BADA), mod);
        p0_filter_mlp(gw, NGW, lane, INF(I_FW1), INF(I_FB1), INF(I_FW2), INF(I_FB2), INF(I_FW3), INF(I_FB3), INF(I_FFREQ), h3);
        p0_tables(gt, NGT, (const int*)args.in[I_POS], rope, tw);
        if (bx == 0 && wave == 0) {
            const float* lq1 = INF(I_LQ1); const float* lk1 = INF(I_LK1); const float* lq2 = INF(I_LQ2); const float* lk2 = INF(I_LK2);
            const float s1 = wave_sum(lq1[lane] * lk1[lane] + lq1[lane + 64] * lk1[lane + 64]), s2 = wave_sum(lq2[lane] * lk2[lane] + lq2[lane + 64] * lk2[lane + 64]);
            if (lane == 0) *(float*)(ctl + CW_LAM) = expf(s1) - expf(s2) + LAM_INIT; }
        p0_weights(gw, NGW, wave, lane, L, INF(I_WIN), INF(I_WOUT), INF(I_WGATE), INF(I_WUP), INF(I_WDOWN), WIN, WOUT, WGU, WDN);
        if (BOTH(0)) GRID_BAR(0);
    }
    if (N_LAUNCHES != PER_PHASE && (G % 8) == 0) {
        bool even = true;
#pragma unroll
        for (int j = 0; j < 8; ++j) even = even && (__hip_atomic_load((unsigned*)(ctl + CW_XRANK + 64 * j), RLX_AGENT) == (unsigned)(G / 8));
        const int rank = __builtin_amdgcn_readfirstlane((int)MISC[16]);
        if (even) { vcu = (int)my_xcc * (G / 8) + rank; cid = rank * 8 + (int)my_xcc; gw = vcu * NWAVES + wave; gt = vcu * NTHR + tid; }
    }
    if (IN(1)) {
        rms_mod_table(tid, L, INF(I_GMIX), mod, 0 * DM, 1 * DM); __syncthreads();
        if (wave < NWAVES / 2) { p1_kern(gw, NGW, lane, h3, INF(I_FW4), KERN); rms_mod_rows(gw, NGW, lane, L, INF(I_X), HA); }
        else { rms_mod_rows(gw, NGW, lane, L, INF(I_X), HA); p1_kern(gw, NGW, lane, h3, INF(I_FW4), KERN); }
        __syncthreads();
        if (BOTH(1)) GRID_BAR(1);
    }
    if (IN(2)) {
        pg8::Gemm g{HA, WIN, M, NIN, DM}; pg8::StaticOrder S; S.init(M, NIN, G, cid);
        pg8::EpiBf16Rope E{PROJ, NIN, (const float*)rope, QOFF / 256, VOFF / 256};
        pg8::gemm_phase<pg8::EpiBf16Rope, pg8::StaticOrder, true, true>(L, g, S, E);
        if (BOTH(2)) GRID_BAR(2);
    }
    if (IN(3)) {
        p3_hyena_pre(vcu, G, tid, L, PROJ, INF(I_CONVW), INF(I_CONVB), VXT, X0T);
        if (BOTH(3)) GRID_BAR(3);
    }
    if (IN(4)) {
        __syncthreads();
        p4_fft(vcu, G, tid, L, KERN, VXT, X0T, INF(I_HBIAS), YT, (f32x2*)(ws + WS_KSPEC) + (size_t)bx * FFTN);
        for (int U = vcu; U < 512; U += G) attn_unit(U, (char*)lds, PROJ, O0, YMIX, (const float*)(ctl + CW_LAM), INF(I_SUBG));
        if (BOTH(4)) GRID_BAR(4);
    }
    if (IN(5)) {
        p5_hyena_post(vcu, G, tid, L, YT, YMIX);
        if (BOTH(5)) GRID_BAR(5);
    }
    if (IN(6)) {
        __syncthreads();
        pg8::Gemm g{YMIX, WOUT, M, DM, DM}; pg8::StaticOrder S; S.init(M, DM, G, cid);
        pg8::EpiGateResB16<false> E{INF(I_X), X1, DM, mod + 2 * DM, NMOD, SEQ / 256};
        pg8::gemm_phase<pg8::EpiGateResB16<false>, pg8::StaticOrder, true, true>(L, g, S, E);
        if (BOTH(6)) GRID_BAR(6);
    }
    if (IN(7)) {
        rms_mod_table(tid, L, INF(I_GFFN), mod, 3 * DM, 4 * DM); __syncthreads();
        rms_mod_rows_b16(gw, NGW, lane, L, X1, HA);
        __syncthreads();
        if (BOTH(7)) GRID_BAR(7);
    }
    if (IN(8)) {
        pg8::Gemm g{HA, WGU, M, NGU, DM}; pg8::StaticOrder S; S.init(M, NGU, G, cid);
        pg8::EpiSwiGlu E{ACT, FFN};
        pg8::gemm_phase<pg8::EpiSwiGlu, pg8::StaticOrder, true, true>(L, g, S, E);
        if (BOTH(8)) GRID_BAR(8);
    }
    if (IN(9)) {
        pg8::Gemm g{ACT, WDN, M, DM, FFN}; pg8::StaticOrder S; S.init(M, DM, G, cid);
        pg8::EpiGateResB16<true> E{X1, X2, DM, mod + 5 * DM, NMOD, SEQ / 256};
        pg8::gemm_phase<pg8::EpiGateResB16<true>, pg8::StaticOrder, true, true>(L, g, S, E);
        if (BOTH(9)) GRID_BAR(9);
    }
    if (IN(10)) {
        rms_final_rows_b16(gw, NGW, lane, X2, args.out, INF(I_GFINAL));
    }
#undef IN
#undef BOTH
#undef INF
}
}

extern "C" void kernel_launch(void* const* d_in, const int* in_sizes, int n_in, void* d_out, int out_size, void* d_ws, size_t ws_size, hipStream_t stream) {
    using namespace mk;
    static int grid = 0;
    if (grid == 0) {
        if (n_in != 29 || in_sizes[0] != M * DM || out_size != M * DM || ws_size < WS_END) {
            fprintf(stderr, "kernel_launch: built for 29 inputs, x/out of %d floats, >= %zu bytes of workspace; got n_in %d, in0 %d, out %d, ws %zu; nothing launched\n", M * DM, (size_t)WS_END, n_in, n_in > 0 ? in_sizes[0] : -1, out_size, ws_size);
            grid = -1; return; }
        int dev = 0, cus = 0, per_cu = 0;
        if (hipGetDevice(&dev) != hipSuccess || hipDeviceGetAttribute(&cus, hipDeviceAttributeMultiprocessorCount, dev) != hipSuccess) { fprintf(stderr, "kernel_launch: device query failed\n"); grid = -1; return; }
        if (hipFuncSetAttribute((const void*)mega_fwd, hipFuncAttributeMaxDynamicSharedMemorySize, LDS_BYTES) != hipSuccess) { fprintf(stderr, "kernel_launch: hipFuncSetAttribute(%d B LDS) failed\n", LDS_BYTES); grid = -1; return; }
        if (hipOccupancyMaxActiveBlocksPerMultiprocessor(&per_cu, (const void*)mega_fwd, NTHR, LDS_BYTES) != hipSuccess || per_cu < 1) {
            fprintf(stderr, "kernel_launch: occupancy query reports %d workgroups per CU; nothing launched\n", per_cu); (void)hipGetLastError(); grid = -1; return; }
        grid = cus > 256 ? 256 : cus;
    }
    if (grid < 0) return;
    if (hipMemsetAsync((char*)d_ws + WS_CTL, 0, CTL_ZERO_BYTES, stream) != hipSuccess) { fprintf(stderr, "kernel_launch: hipMemsetAsync failed\n"); return; }
    Args a{};
    for (int i = 0; i < 29; ++i) a.in[i] = d_in[i];
    a.out = (float*)d_out; a.ws = (unsigned char*)d_ws;
    if (N_LAUNCHES == 1) {
        a.ph_lo = 0; a.ph_hi = PER_PHASE;
        hipLaunchKernelGGL(mega_fwd, dim3(grid), dim3(NTHR), LDS_BYTES, stream, a);
    } else {
        for (int p = 0; p < PER_PHASE; ++p) { a.ph_lo = p; a.ph_hi = p + 1; hipLaunchKernelGGL(mega_fwd, dim3(grid), dim3(NTHR), LDS_BYTES, stream, a); }
    }
    const hipError_t le = hipPeekAtLastError();
    if (le != hipSuccess) fprintf(stderr, "kernel_launch: launch failed: %s (grid %d x %d threads, %d B LDS)\n", hipGetErrorName(le), grid, NTHR, LDS_BYTES);
}
```

```cpp
#include <hip/hip_runtime.h>
#include <hip/hip_bf16.h>
#include <cstdio>
#include <cstdint>
#ifndef MK_N_LAUNCHES
#define MK_N_LAUNCHES 1
#endif
namespace pg8 {
#define PG8_LAS __attribute__((address_space(3)))
typedef unsigned short bf16_t;
typedef short bf16x8 __attribute__((ext_vector_type(8)));
typedef float f32x4 __attribute__((ext_vector_type(4)));
typedef unsigned u32x4 __attribute__((ext_vector_type(4)));
constexpr int BM = 256, BK = 64, HALF = 128, HTB = HALF * BK * 2  , STAGE_BYTES = 8 * HTB, NXCD = 8, WGM = 4;

__host__ __device__ __forceinline__ int lds_byte(int r, int c) { const int st = (r >> 4) * 2 + (c >> 5), rr = r & 15, cc = c & 31, ob = rr * 64 + cc * 2; return st * 1024 + (ob ^ (((ob >> 9) & 1) << 5)); }
__host__ __device__ __forceinline__ void stage_rc(int b, int& R, int& C) { const int st = b / 1024, sb = b % 1024, swz = sb ^ (((sb >> 9) & 1) << 5); R = (st >> 1) * 16 + swz / 64; C = (st & 1) * 32 + (swz % 64) / 2; }
__host__ __device__ __forceinline__ int perm32(int rho) { const int n = rho >> 4, i = rho & 15; return 8 * (i >> 2) + 4 * n + (i & 3); }

struct Unit { int pm, pn; };
struct Gemm { const bf16_t* A; const bf16_t* Bt; int M, N, K; };

struct StaticOrder {
    int nM, nN, nwg, G, c;
    __host__ __device__ void init(int M, int N, int G_, int c_) { nM = M / BM; nN = N / BM; nwg = nM * nN; G = G_; c = c_; }
    __host__ __device__ bool next(int i, Unit& u) const {
        const long L = (long)i * G + c; if (L >= nwg) return false;
        int wgid = (int)L; { const int q = nwg / NXCD, r = nwg % NXCD, xcd = wgid % NXCD, off = wgid / NXCD; wgid = (xcd < r ? xcd * (q + 1) : r * (q + 1) + (xcd - r) * q) + off; }
        const int nig = WGM * nN, gid = wgid / nig, fm = gid * WGM, gsz = (nM - fm) < WGM ? (nM - fm) : WGM;
        u.pm = fm + ((wgid % nig) % gsz); u.pn = (wgid % nig) / gsz; return true;
    }
    __device__ __forceinline__ void a_ready(const Unit&) const {}
    __device__ __forceinline__ void done(const Unit&) const {}
};

__device__ __forceinline__ unsigned cvt_pk_bf16(float lo, float hi) { unsigned r; asm volatile("v_cvt_pk_bf16_f32 %0, %1, %2" : "=v"(r) : "v"(lo), "v"(hi)); return r; }
typedef float f32x2 __attribute__((ext_vector_type(2)));
struct EpiBf16 {
    static constexpr bool PERM = true, AFTER_DRAIN = false;
    bf16_t* O; int ldc;
    __device__ __forceinline__ void operator()(const f32x4 (&acc)[2][2][4][2], const Unit& u, int wr, int wc, int fr, int fq) const {
        const int row0 = u.pm * BM + wr * 64 + fr, col0 = u.pn * BM + wc * 32 + 8 * fq;
#pragma unroll
        for (int ai = 0; ai < 2; ++ai)
#pragma unroll
            for (int m = 0; m < 4; ++m) { bf16_t* rowp = O + (size_t)(row0 + ai * HALF + m * 16) * ldc + col0;
#pragma unroll
                for (int bj = 0; bj < 2; ++bj) { const f32x4 v0 = acc[ai][bj][m][0], v1 = acc[ai][bj][m][1];
                    u32x4 w; w.x = cvt_pk_bf16(v0[0], v0[1]); w.y = cvt_pk_bf16(v0[2], v0[3]); w.z = cvt_pk_bf16(v1[0], v1[1]); w.w = cvt_pk_bf16(v1[2], v1[3]);
                    *(u32x4*)(rowp + bj * HALF) = w; } }
    }
};
struct EpiSwiGlu {
    static constexpr bool PERM = true, AFTER_DRAIN = false;
    bf16_t* O; int ldc;
    __device__ __forceinline__ void operator()(const f32x4 (&acc)[2][2][4][2], const Unit& u, int wr, int wc, int fr, int fq) const {
        const int row0 = u.pm * BM + wr * 64 + fr, col0 = u.pn * HALF + wc * 32 + 8 * fq;
#pragma unroll
        for (int ai = 0; ai < 2; ++ai)
#pragma unroll
            for (int m = 0; m < 4; ++m) { bf16_t* rowp = O + (size_t)(row0 + ai * HALF + m * 16) * ldc + col0;
                float r[8];
#pragma unroll
                for (int n = 0; n < 2; ++n)
#pragma unroll
                    for (int i = 0; i < 4; ++i) { const float g = acc[ai][0][m][n][i], up = acc[ai][1][m][n][i];
                        r[n * 4 + i] = g * up * __builtin_amdgcn_rcpf(1.0f + __builtin_amdgcn_exp2f(-1.4426950408889634f * g)); }
                u32x4 w; w.x = cvt_pk_bf16(r[0], r[1]); w.y = cvt_pk_bf16(r[2], r[3]); w.z = cvt_pk_bf16(r[4], r[5]); w.w = cvt_pk_bf16(r[6], r[7]);
                *(u32x4*)rowp = w; }
    }
};
struct EpiGateRes {
    static constexpr bool PERM = false, AFTER_DRAIN = false;
    const float* base; float* out; int ldc; const float* gate; int gate_pitch; int tiles_per_batch;
    __device__ __forceinline__ void operator()(const f32x4 (&acc)[2][2][4][2], const Unit& u, int wr, int wc, int fr, int fq) const {
        const int row0 = u.pm * BM + wr * 64 + fr, col0 = u.pn * BM + wc * 32 + 4 * fq;
        const float* g = gate + (size_t)(u.pm / tiles_per_batch) * gate_pitch + col0;
        f32x4 gv[2][2];
#pragma unroll
        for (int bj = 0; bj < 2; ++bj)
#pragma unroll
            for (int n = 0; n < 2; ++n) gv[bj][n] = *(const f32x4*)(g + bj * HALF + n * 16);
#pragma unroll
        for (int ai = 0; ai < 2; ++ai) {
            f32x4 bs[4][2][2];
#pragma unroll
            for (int m = 0; m < 4; ++m) { const size_t off = (size_t)(row0 + ai * HALF + m * 16) * ldc + col0;
#pragma unroll
                for (int bj = 0; bj < 2; ++bj)
#pragma unroll
                    for (int n = 0; n < 2; ++n) bs[m][bj][n] = *(const f32x4*)(base + off + bj * HALF + n * 16); }
            asm volatile("" ::: "memory");
#pragma unroll
            for (int m = 0; m < 4; ++m) { const size_t off = (size_t)(row0 + ai * HALF + m * 16) * ldc + col0;
#pragma unroll
                for (int bj = 0; bj < 2; ++bj)
#pragma unroll
                    for (int n = 0; n < 2; ++n) *(f32x4*)(out + off + bj * HALF + n * 16) = bs[m][bj][n] + gv[bj][n] * acc[ai][bj][m][n]; }
            asm volatile("" ::: "memory"); }
    }
};
struct EpiBf16Rope {
    static constexpr bool PERM = true, AFTER_DRAIN = false;
    bf16_t* O; int ldc; const float* rope; int pn_lo, pn_hi;
    __device__ __forceinline__ void operator()(const f32x4 (&acc)[2][2][4][2], const Unit& u, int wr, int wc, int fr, int fq) const {
        const int row0 = u.pm * BM + wr * 64 + fr;
        if (u.pn < pn_lo || u.pn >= pn_hi) {
            const int col0 = u.pn * BM + wc * 32 + 8 * fq;
#pragma unroll
            for (int ai = 0; ai < 2; ++ai)
#pragma unroll
                for (int m = 0; m < 4; ++m) { bf16_t* rowp = O + (size_t)(row0 + ai * HALF + m * 16) * ldc + col0;
#pragma unroll
                    for (int bj = 0; bj < 2; ++bj) { const f32x4 v0 = acc[ai][bj][m][0], v1 = acc[ai][bj][m][1];
                        u32x4 w; w.x = cvt_pk_bf16(v0[0], v0[1]); w.y = cvt_pk_bf16(v0[2], v0[3]); w.z = cvt_pk_bf16(v1[0], v1[1]); w.w = cvt_pk_bf16(v1[2], v1[3]);
                        *(u32x4*)(rowp + bj * HALF) = w; } }
        } else {
            const int cp = wc * 32 + 8 * fq, d0 = cp & 63, colA = u.pn * BM + (cp < 64 ? cp : cp + 64);
#pragma unroll
            for (int ai = 0; ai < 2; ++ai) {
                f32x4 t[4][4];
#pragma unroll
                for (int m = 0; m < 4; ++m) { const f32x4* cs = (const f32x4*)(rope + ((size_t)(row0 + ai * HALF + m * 16) * 64 + d0) * 2);
                    t[m][0] = cs[0]; t[m][1] = cs[1]; t[m][2] = cs[2]; t[m][3] = cs[3]; }
                asm volatile("" ::: "memory");
#pragma unroll
                for (int m = 0; m < 4; ++m) { const int row = row0 + ai * HALF + m * 16;
                    const f32x4 t0 = t[m][0], t1 = t[m][1], t2 = t[m][2], t3 = t[m][3];
                    const f32x4 a0 = acc[ai][0][m][0], a1 = acc[ai][0][m][1], b0 = acc[ai][1][m][0], b1 = acc[ai][1][m][1];
                    u32x4 w1, w2;
                    w1.x = cvt_pk_bf16(a0[0] * t0[0] - b0[0] * t0[1], a0[1] * t0[2] - b0[1] * t0[3]); w2.x = cvt_pk_bf16(b0[0] * t0[0] + a0[0] * t0[1], b0[1] * t0[2] + a0[1] * t0[3]);
                    w1.y = cvt_pk_bf16(a0[2] * t1[0] - b0[2] * t1[1], a0[3] * t1[2] - b0[3] * t1[3]); w2.y = cvt_pk_bf16(b0[2] * t1[0] + a0[2] * t1[1], b0[3] * t1[2] + a0[3] * t1[3]);
                    w1.z = cvt_pk_bf16(a1[0] * t2[0] - b1[0] * t2[1], a1[1] * t2[2] - b1[1] * t2[3]); w2.z = cvt_pk_bf16(b1[0] * t2[0] + a1[0] * t2[1], b1[1] * t2[2] + a1[1] * t2[3]);
                    w1.w = cvt_pk_bf16(a1[2] * t3[0] - b1[2] * t3[1], a1[3] * t3[2] - b1[3] * t3[3]); w2.w = cvt_pk_bf16(b1[2] * t3[0] + a1[2] * t3[1], b1[3] * t3[2] + a1[3] * t3[3]);
                    bf16_t* rowp = O + (size_t)row * ldc + colA;
                    *(u32x4*)rowp = w1; *(u32x4*)(rowp + 64) = w2; }
                asm volatile("" ::: "memory"); }
        }
    }
};
template <bool BASE16> struct EpiGateResB16 {
    static constexpr bool PERM = true, AFTER_DRAIN = false;
    const void* base; bf16_t* out; int ldc; const float* gate; int gate_pitch; int tiles_per_batch;
    __device__ __forceinline__ void operator()(const f32x4 (&acc)[2][2][4][2], const Unit& u, int wr, int wc, int fr, int fq) const {
        const int row0 = u.pm * BM + wr * 64 + fr, col0 = u.pn * BM + wc * 32 + 8 * fq;
        const float* g = gate + (size_t)(u.pm / tiles_per_batch) * gate_pitch + col0;
        f32x4 gv[2][2];
#pragma unroll
        for (int bj = 0; bj < 2; ++bj)
#pragma unroll
            for (int n = 0; n < 2; ++n) gv[bj][n] = *(const f32x4*)(g + bj * HALF + 4 * n);
#pragma unroll
        for (int ai = 0; ai < 2; ++ai) {
            f32x4 bs[4][2][2];
#pragma unroll
            for (int m = 0; m < 4; ++m) { const size_t off = (size_t)(row0 + ai * HALF + m * 16) * ldc + col0;
#pragma unroll
                for (int bj = 0; bj < 2; ++bj) {
                    if constexpr (BASE16) { const u32x4 w = *(const u32x4*)((const bf16_t*)base + off + bj * HALF);
                        bs[m][bj][0] = (f32x4){__builtin_bit_cast(float, w.x << 16), __builtin_bit_cast(float, w.x & 0xffff0000u), __builtin_bit_cast(float, w.y << 16), __builtin_bit_cast(float, w.y & 0xffff0000u)};
                        bs[m][bj][1] = (f32x4){__builtin_bit_cast(float, w.z << 16), __builtin_bit_cast(float, w.z & 0xffff0000u), __builtin_bit_cast(float, w.w << 16), __builtin_bit_cast(float, w.w & 0xffff0000u)}; }
                    else { bs[m][bj][0] = *(const f32x4*)((const float*)base + off + bj * HALF); bs[m][bj][1] = *(const f32x4*)((const float*)base + off + bj * HALF + 4); } } }
            asm volatile("" ::: "memory");
#pragma unroll
            for (int m = 0; m < 4; ++m) { const size_t off = (size_t)(row0 + ai * HALF + m * 16) * ldc + col0;
#pragma unroll
                for (int bj = 0; bj < 2; ++bj) { const f32x4 v0 = bs[m][bj][0] + gv[bj][0] * acc[ai][bj][m][0], v1 = bs[m][bj][1] + gv[bj][1] * acc[ai][bj][m][1];
                    u32x4 w; w.x = cvt_pk_bf16(v0[0], v0[1]); w.y = cvt_pk_bf16(v0[2], v0[3]); w.z = cvt_pk_bf16(v1[0], v1[1]); w.w = cvt_pk_bf16(v1[2], v1[3]);
                    *(u32x4*)(out + off + bj * HALF) = w; } }
            asm volatile("" ::: "memory"); }
    }
};
template <class Epi, class Sched, bool ALIGN_EPI = false, bool SP2 = false>
__device__ __forceinline__ void gemm_phase(PG8_LAS unsigned char* lds, const Gemm g, const Sched& S, const Epi& E) {
    const int tid = threadIdx.x, wid = __builtin_amdgcn_readfirstlane(tid >> 6), lane = tid & 63, wr = wid >> 2, wc = wid & 3, fr = lane & 15, fq = lane >> 4;
    const int K = g.K, nt = K / BK;
    unsigned voffA[2], voffB[2];
#pragma unroll
    for (int i = 0; i < 2; ++i) { int R, C; stage_rc(tid * 16 + i * 8192, R, C); const int Rb = Epi::PERM ? ((R & ~31) + perm32(R & 31)) : R;
        voffA[i] = (unsigned)(R * K + C) * 2u; voffB[i] = (unsigned)(Rb * K + C) * 2u; }
    const size_t kstep = (size_t)(BK * 2);
    const size_t hstep = (size_t)HALF * K * 2;
    const size_t tstep = 2 * hstep;
    const unsigned ldsw = (unsigned)wid * 1024u;
    const int aoff = lds_byte(wr * 64 + fr, fq * 8), boff = lds_byte(wc * 32 + fr, fq * 8);
#define PG8_SA(b, h) (((b) * 2 + (h)) * HTB)
#define PG8_SB(b, h) ((4 + (b) * 2 + (h)) * HTB)
#define PG8_STAGE(bufoff, gbase, voff) do { _Pragma("unroll") for (int _i = 0; _i < 2; ++_i) \
        __builtin_amdgcn_global_load_lds((const unsigned*)((const char*)(gbase) + (voff)[_i]), (PG8_LAS unsigned*)(lds + (bufoff) + ldsw + _i * 8192), 16, 0, 0); } while (0)
#define PG8_LDA(dst, b, h) do { _Pragma("unroll") for (int m = 0; m < 4; ++m) _Pragma("unroll") for (int k = 0; k < 2; ++k) dst[m][k] = *(const PG8_LAS bf16x8*)(lds + PG8_SA(b, h) + aoff + m * 2048 + k * 1024); } while (0)
#define PG8_LDB(dst, b, h) do { _Pragma("unroll") for (int n = 0; n < 2; ++n) _Pragma("unroll") for (int k = 0; k < 2; ++k) dst[n][k] = *(const PG8_LAS bf16x8*)(lds + PG8_SB(b, h) + boff + n * 2048 + k * 1024); } while (0)
#define PG8_MMA(ai, bj, At, Bt) do { __builtin_amdgcn_s_setprio(1); _Pragma("unroll") for (int m = 0; m < 4; ++m) _Pragma("unroll") for (int n = 0; n < 2; ++n) _Pragma("unroll") for (int k = 0; k < 2; ++k) \
        acc[ai][bj][m][n] = __builtin_amdgcn_mfma_f32_16x16x32_bf16(Bt[n][k], At[m][k], acc[ai][bj][m][n], 0, 0, 0); __builtin_amdgcn_s_setprio(0); } while (0)
#define PG8_WAIT_V(n) asm volatile("s_waitcnt vmcnt(" #n ")" ::: "memory")
#define PG8_WAIT_L(n) asm volatile("s_waitcnt lgkmcnt(" #n ")" ::: "memory")
#define PG8_BAR __builtin_amdgcn_s_barrier()
#define PG8_SCHED __builtin_amdgcn_sched_barrier(0)
    Unit cur, nxt; int ui = 0;
    if (!S.next(0, cur)) return;
    f32x4 acc[2][2][4][2];
#pragma unroll
    for (int a = 0; a < 2; ++a)
#pragma unroll
        for (int b = 0; b < 2; ++b)
#pragma unroll
            for (int m = 0; m < 4; ++m)
#pragma unroll
                for (int n = 0; n < 2; ++n) acc[a][b][m][n] = (f32x4){0.f, 0.f, 0.f, 0.f};
    bf16x8 At[4][2], B0[2][2], B1[2][2];
    const char* cA = (const char*)g.A + (size_t)cur.pm * tstep; const char* cB = (const char*)g.Bt + (size_t)cur.pn * tstep;
    S.a_ready(cur);
    if constexpr (SP2) {
        PG8_STAGE(PG8_SB(0, 0), cB, voffB); PG8_STAGE(PG8_SB(0, 1), cB + hstep, voffB); PG8_STAGE(PG8_SA(0, 0), cA, voffA); PG8_STAGE(PG8_SA(0, 1), cA + hstep, voffA);
        if (wr == 1) PG8_BAR;
        PG8_WAIT_V(2); PG8_BAR;
        PG8_STAGE(PG8_SB(1, 0), cB + kstep, voffB); PG8_STAGE(PG8_SA(1, 0), cA + kstep, voffA); PG8_STAGE(PG8_SB(1, 1), cB + hstep + kstep, voffB);
        PG8_WAIT_V(6); PG8_BAR;
    } else {
        PG8_STAGE(PG8_SB(0, 0), cB, voffB); PG8_STAGE(PG8_SA(0, 0), cA, voffA); PG8_STAGE(PG8_SB(0, 1), cB + hstep, voffB); PG8_STAGE(PG8_SA(0, 1), cA + hstep, voffA);
        if (wr == 1) PG8_BAR;
        PG8_WAIT_V(4); PG8_BAR;
        PG8_STAGE(PG8_SB(1, 0), cB + kstep, voffB); PG8_STAGE(PG8_SA(1, 0), cA + kstep, voffA); PG8_STAGE(PG8_SB(1, 1), cB + hstep + kstep, voffB);
        PG8_WAIT_V(6); PG8_BAR;
    }
    for (;;) {
        const bool has_next = S.next(ui + 1, nxt);
        const char* nA = has_next ? (const char*)g.A + (size_t)nxt.pm * tstep : cA; const char* nB = has_next ? (const char*)g.Bt + (size_t)nxt.pn * tstep : cB;
        for (int t = 0; t < nt; t += 2) {
            const bool last = (t == nt - 2);
            const char* a1 = cA + (size_t)(t + 1) * kstep;
            const char* a2 = last ? nA : cA + (size_t)(t + 2) * kstep; const char* b2 = last ? nB : cB + (size_t)(t + 2) * kstep;
            const char* a3 = a2 + kstep; const char* b3 = b2 + kstep;
            if (last && has_next) S.a_ready(nxt);
            if constexpr (SP2) {
            PG8_LDB(B0, 0, 0); PG8_LDB(B1, 0, 1); PG8_SCHED; PG8_LDA(At, 0, 0); PG8_STAGE(PG8_SA(1, 1), a1 + hstep, voffA);
            PG8_WAIT_V(8); PG8_WAIT_L(0); PG8_BAR; PG8_MMA(0, 0, At, B0); PG8_MMA(0, 1, At, B1); PG8_BAR; PG8_SCHED;
            PG8_LDA(At, 0, 1); PG8_STAGE(PG8_SB(0, 0), b2, voffB); PG8_STAGE(PG8_SB(0, 1), b2 + hstep, voffB); PG8_STAGE(PG8_SA(0, 0), a2, voffA);
            PG8_WAIT_V(8); PG8_WAIT_L(0); PG8_BAR; PG8_MMA(1, 0, At, B0); PG8_MMA(1, 1, At, B1); PG8_BAR; PG8_SCHED;
            PG8_LDB(B0, 1, 0); PG8_LDB(B1, 1, 1); PG8_SCHED; PG8_LDA(At, 1, 0); PG8_STAGE(PG8_SA(0, 1), a2 + hstep, voffA);
            PG8_WAIT_V(8); PG8_WAIT_L(0); PG8_BAR; PG8_MMA(0, 0, At, B0); PG8_MMA(0, 1, At, B1); PG8_BAR; PG8_SCHED;
            PG8_LDA(At, 1, 1); PG8_STAGE(PG8_SB(1, 0), b3, voffB); PG8_STAGE(PG8_SB(1, 1), b3 + hstep, voffB); PG8_STAGE(PG8_SA(1, 0), a3, voffA);
            PG8_WAIT_V(8); PG8_WAIT_L(0); PG8_BAR; PG8_MMA(1, 0, At, B0); PG8_MMA(1, 1, At, B1); PG8_BAR; PG8_SCHED;
            } else {
            PG8_LDB(B0, 0, 0); PG8_SCHED; PG8_LDA(At, 0, 0); PG8_STAGE(PG8_SA(1, 1), a1 + hstep, voffA);
            PG8_WAIT_L(8); PG8_BAR; PG8_WAIT_L(0); PG8_MMA(0, 0, At, B0); PG8_BAR; PG8_SCHED;
            PG8_LDB(B1, 0, 1); PG8_STAGE(PG8_SB(0, 0), b2, voffB);
            PG8_BAR; PG8_WAIT_L(0); PG8_MMA(0, 1, At, B1); PG8_BAR;
            PG8_LDA(At, 0, 1); PG8_STAGE(PG8_SA(0, 0), a2, voffA);
            PG8_BAR; PG8_WAIT_L(0); PG8_MMA(1, 0, At, B0); PG8_BAR; PG8_SCHED;
            PG8_STAGE(PG8_SB(0, 1), b2 + hstep, voffB);
            PG8_WAIT_V(6); PG8_BAR; PG8_MMA(1, 1, At, B1); PG8_BAR;
            PG8_LDB(B0, 1, 0); PG8_SCHED; PG8_LDA(At, 1, 0); PG8_STAGE(PG8_SA(0, 1), a2 + hstep, voffA);
            PG8_WAIT_L(8); PG8_BAR; PG8_WAIT_L(0); PG8_MMA(0, 0, At, B0); PG8_BAR; PG8_SCHED;
            PG8_LDB(B1, 1, 1); PG8_STAGE(PG8_SB(1, 0), b3, voffB);
            PG8_BAR; PG8_WAIT_L(0); PG8_MMA(0, 1, At, B1); PG8_BAR;
            PG8_LDA(At, 1, 1); PG8_STAGE(PG8_SA(1, 0), a3, voffA);
            PG8_BAR; PG8_WAIT_L(0); PG8_MMA(1, 0, At, B0); PG8_BAR; PG8_SCHED;
            PG8_STAGE(PG8_SB(1, 1), b3 + hstep, voffB);
            PG8_WAIT_V(6); PG8_BAR; PG8_MMA(1, 1, At, B1); PG8_BAR;
            }
        }
        if constexpr (ALIGN_EPI) { if (wr == 0) PG8_BAR; }
        if constexpr (!Epi::AFTER_DRAIN) { E(acc, cur, wr, wc, fr, fq); S.done(cur); }
        if (!has_next) break;
#pragma unroll
        for (int a = 0; a < 2; ++a)
#pragma unroll
            for (int b = 0; b < 2; ++b)
#pragma unroll
                for (int m = 0; m < 4; ++m)
#pragma unroll
                    for (int n = 0; n < 2; ++n) acc[a][b][m][n] = (f32x4){0.f, 0.f, 0.f, 0.f};
        cur = nxt; cA = nA; cB = nB; ++ui;
        if constexpr (ALIGN_EPI) { if (wr == 1) PG8_BAR; }
    }
    PG8_WAIT_V(0);
    if constexpr (!ALIGN_EPI) { if (wr == 0) PG8_BAR; }
    PG8_BAR;
    if constexpr (Epi::AFTER_DRAIN) { E.fused(acc, cur, wr, wc, fr, fq, lds, wid, lane); S.done(cur); }
#undef PG8_SA
#undef PG8_SB
#undef PG8_STAGE
#undef PG8_LDA
#undef PG8_LDB
#undef PG8_MMA
#undef PG8_WAIT_V
#undef PG8_WAIT_L
#undef PG8_BAR
#undef PG8_SCHED
}
}
namespace att {
typedef float f32x4v __attribute__((ext_vector_type(4)));
using bf16 = __hip_bfloat16;
constexpr int   D = 128, NW = 8, QBLK = 32, KVBLK = 64;
constexpr float SCALE = 0.088388347648318440f;
constexpr float THR = 8.f;
constexpr int SDEPTH = 2;
constexpr int LDQ = 12288, LDK = 12288, LDO = 2048;
constexpr size_t SHM_V = KVBLK * D * 2, SHM_K = KVBLK * D * 2, SHM_ATTN = 2 * SHM_V + 2 * SHM_K + NW * 64 * 4;
using bf16x8 = __attribute__((ext_vector_type(8))) short;
using s16x4  = __attribute__((ext_vector_type(4))) short;
using f32x16 = __attribute__((ext_vector_type(16))) float;
using f32x8  = __attribute__((ext_vector_type(8))) float;
using u32x4  = __attribute__((ext_vector_type(4))) unsigned;
#define KSWZ(row, colB) ((row) * 256 + ((colB) ^ (((row) & 7) << 4)))
#define SBAR() __builtin_amdgcn_sched_barrier(0)
__device__ __forceinline__ int crow(int r, int hi) { return (r & 3) + 8 * (r >> 2) + 4 * hi; }
__device__ __forceinline__ unsigned cvtpk(float lo, float hi) {
  unsigned r; asm volatile("v_cvt_pk_bf16_f32 %0, %1, %2" : "=v"(r) : "v"(lo), "v"(hi)); return r;
}
template <typename TIn> struct Stage;
template <> struct Stage<bf16>  { using T = bf16x8;
  __device__ static __forceinline__ T ld8(const bf16* p) { return *reinterpret_cast<const bf16x8*>(p); }
  __device__ static __forceinline__ bf16x8 tobf(T x) { return x; } };
template <> struct Stage<float> { using T = f32x8;
  __device__ static __forceinline__ T ld8(const float* p) { return *reinterpret_cast<const f32x8*>(p); }
  __device__ static __forceinline__ bf16x8 tobf(T x) {
    u32x4 w = {cvtpk(x[0], x[1]), cvtpk(x[2], x[3]), cvtpk(x[4], x[5]), cvtpk(x[6], x[7])}; return *reinterpret_cast<bf16x8*>(&w); } };

__device__ __forceinline__ void partialSM(f32x16& p0, f32x16& p1, float& m_reg, float& mn, float& alpha) {
  constexpr float C = SCALE * 1.4426950408889634f;
  float pmax = p0[0]; for (int r = 1; r < 16; ++r) pmax = fmaxf(pmax, p0[r]); for (int r = 0; r < 16; ++r) pmax = fmaxf(pmax, p1[r]);
  { auto rr = __builtin_amdgcn_permlane32_swap(__float_as_uint(pmax), __float_as_uint(pmax), false, false);
    pmax = fmaxf(__uint_as_float(rr[0]), __uint_as_float(rr[1])); }
  if (__builtin_expect(__all(pmax - m_reg <= THR / SCALE), 1)) { mn = m_reg; alpha = 1.f; }
  else { mn = fmaxf(m_reg, pmax); alpha = __builtin_amdgcn_exp2f((m_reg - mn) * C); m_reg = mn; }
  float mnC = -mn * C;
  for (int r = 0; r < 16; ++r) p0[r] = fmaf(p0[r], C, mnC); for (int r = 0; r < 16; ++r) p1[r] = fmaf(p1[r], C, mnC);
  for (int r = 0; r < 16; ++r) p0[r] = __builtin_amdgcn_exp2f(p0[r]);
}
__device__ __forceinline__ void finishSM(f32x16& p0, f32x16& p1, float alpha, float& l_reg, bf16x8& pa0, bf16x8& pa1, bf16x8& pa2, bf16x8& pa3) {
  for (int r = 0; r < 16; ++r) p1[r] = __builtin_amdgcn_exp2f(p1[r]);
  float ps = 0; for (int r = 0; r < 16; ++r) ps += p0[r]; for (int r = 0; r < 16; ++r) ps += p1[r];
  { auto rr = __builtin_amdgcn_permlane32_swap(__float_as_uint(ps), __float_as_uint(ps), false, false);
    ps = __uint_as_float(rr[0]) + __uint_as_float(rr[1]); }
  l_reg = l_reg * alpha + ps;
#define PK4(P, BASE, OUT) do { unsigned a0 = cvtpk(P[BASE + 0], P[BASE + 1]), a1 = cvtpk(P[BASE + 2], P[BASE + 3]);   \
    unsigned b0 = cvtpk(P[BASE + 4], P[BASE + 5]), b1 = cvtpk(P[BASE + 6], P[BASE + 7]);                              \
    auto r0 = __builtin_amdgcn_permlane32_swap(a0, b0, false, false); auto r1 = __builtin_amdgcn_permlane32_swap(a1, b1, false, false); \
    u32x4 w = {r0[0], r1[0], r0[1], r1[1]}; OUT = *reinterpret_cast<bf16x8*>(&w); } while (0)
  PK4(p0, 0, pa0); PK4(p0, 8, pa1); PK4(p1, 0, pa2); PK4(p1, 8, pa3);
#undef PK4
}
__device__ __forceinline__ void qkt(f32x16& p0, f32x16& p1, const bf16* Ks, const bf16x8* qr, int r32, int hi) {
  p0 = f32x16{}; p1 = f32x16{};
  for (int d0 = 0; d0 < 8; ++d0) { int cb = (d0 * 16 + hi * 8) * 2;
    bf16x8 b0 = *reinterpret_cast<const bf16x8*>((const char*)Ks + KSWZ(r32, cb));
    bf16x8 b1 = *reinterpret_cast<const bf16x8*>((const char*)Ks + KSWZ(32 + r32, cb));
    p0 = __builtin_amdgcn_mfma_f32_32x32x16_bf16(b0, qr[d0], p0, 0, 0, 0);
    p1 = __builtin_amdgcn_mfma_f32_32x32x16_bf16(b1, qr[d0], p1, 0, 0, 0); }
}
__device__ __forceinline__ int v_st(int k, int c) { const int kk = (k & ~0xC) | ((k & 4) << 1) | ((k & 8) >> 1); return ((kk >> 3) * 4 + (c >> 5)) * 512 + ((kk & 7) * 32 + (c & 31)) * 2; }
__device__ __forceinline__ int v_rd_base(int lane) { return ((lane & 3) << 3) | (((lane >> 2) & 3) << 6) | (((lane >> 4) & 1) << 5) | (((lane >> 5) & 1) << 8); }
constexpr int v_rd_off(int d0, int ks, int half) { return d0 * 512 + ks * 4096 + half * 2048; }
template <int OFF> __device__ __forceinline__ s16x4 tr_read(int vb) {
  s16x4 r; asm volatile("ds_read_b64_tr_b16 %0, %1 offset:%2" : "=&v"(r) : "v"(vb), "i"(OFF) : "memory"); return r;
}
template <int D0> __device__ __forceinline__ void pv_one(f32x16& od, int vb, bf16x8 pa0, bf16x8 pa1, bf16x8 pa2, bf16x8 pa3) {
  const s16x4 l0 = tr_read<v_rd_off(D0, 0, 0)>(vb), h0 = tr_read<v_rd_off(D0, 0, 1)>(vb), l1 = tr_read<v_rd_off(D0, 1, 0)>(vb), h1 = tr_read<v_rd_off(D0, 1, 1)>(vb);
  const s16x4 l2 = tr_read<v_rd_off(D0, 2, 0)>(vb), h2 = tr_read<v_rd_off(D0, 2, 1)>(vb), l3 = tr_read<v_rd_off(D0, 3, 0)>(vb), h3 = tr_read<v_rd_off(D0, 3, 1)>(vb);
  asm volatile("s_waitcnt lgkmcnt(0)" ::: "memory"); SBAR();
#define PK(L, H) (bf16x8){L[0], L[1], L[2], L[3], H[0], H[1], H[2], H[3]}
  od = __builtin_amdgcn_mfma_f32_32x32x16_bf16(pa0, PK(l0, h0), od, 0, 0, 0);
  od = __builtin_amdgcn_mfma_f32_32x32x16_bf16(pa1, PK(l1, h1), od, 0, 0, 0);
  od = __builtin_amdgcn_mfma_f32_32x32x16_bf16(pa2, PK(l2, h2), od, 0, 0, 0);
  od = __builtin_amdgcn_mfma_f32_32x32x16_bf16(pa3, PK(l3, h3), od, 0, 0, 0);
#undef PK
}
__device__ __forceinline__ void pv_d0(f32x16* o, int vb, bf16x8 pa0, bf16x8 pa1, bf16x8 pa2, bf16x8 pa3) {
  pv_one<0>(o[0], vb, pa0, pa1, pa2, pa3); pv_one<1>(o[1], vb, pa0, pa1, pa2, pa3); pv_one<2>(o[2], vb, pa0, pa1, pa2, pa3); pv_one<3>(o[3], vb, pa0, pa1, pa2, pa3);
}

template <typename TQ>
__device__ __forceinline__ void attn_dense_body(const TQ* __restrict__ Qb, const bf16* __restrict__ Kh, const bf16* __restrict__ Vh,
                                                float* __restrict__ Ob, int seq, char* lds) {
  using St = Stage<bf16>; using SQ = Stage<TQ>;
  const int tid = threadIdx.x, wid = tid >> 6, lane = tid & 63, r32 = lane & 31, hi = lane >> 5;
  bf16* V_lds = (bf16*)lds; bf16* K_lds = (bf16*)(lds + 2 * SHM_V);
  float* ws = (float*)(lds + 2 * SHM_V + 2 * SHM_K) + wid * 64; float* li_l = ws; float* al_l = ws + 32;
  float m_reg = -1e30f, l_reg = 0; f32x16 o[4] = {}; bf16x8 qr[8];
  const TQ* Qw = Qb + (long)(wid * QBLK + r32) * LDQ + hi * 8;
#pragma unroll
  for (int d0 = 0; d0 < 8; ++d0) qr[d0] = SQ::tobf(SQ::ld8(Qw + d0 * 16));
  const int sr = tid >> 4, sc = (tid & 15) * 8, vst0 = v_st(sr, sc), vst1 = v_st(32 + sr, sc);
  const int vb0 = (int)(uintptr_t)V_lds + v_rd_base(lane);
  struct { typename St::T vs0, vs1, ks0, ks1; } sr_[SDEPTH];
#define SLOAD(i, k0) do { sr_[i].vs0 = St::ld8(&Vh[(long)((k0) + sr) * LDK + sc]); sr_[i].vs1 = St::ld8(&Vh[(long)((k0) + 32 + sr) * LDK + sc]); \
    sr_[i].ks0 = St::ld8(&Kh[(long)((k0) + sr) * LDK + sc]); sr_[i].ks1 = St::ld8(&Kh[(long)((k0) + 32 + sr) * LDK + sc]); } while (0)
#define SWRITE(b, i) do { *(bf16x8*)((char*)V_lds + (b) * SHM_V + vst0) = St::tobf(sr_[i].vs0);          \
    *(bf16x8*)((char*)V_lds + (b) * SHM_V + vst1) = St::tobf(sr_[i].vs1); int kc = sc * 2;               \
    *(bf16x8*)((char*)K_lds + (b) * SHM_K + KSWZ(sr, kc)) = St::tobf(sr_[i].ks0);                       \
    *(bf16x8*)((char*)K_lds + (b) * SHM_K + KSWZ(32 + sr, kc)) = St::tobf(sr_[i].ks1); } while (0)
#define SWAIT() do { if constexpr (SDEPTH == 2) asm volatile("s_waitcnt vmcnt(4)" ::: "memory"); else asm volatile("s_waitcnt vmcnt(0)" ::: "memory"); } while (0)
#define RESC(a) do { if (__any((a) < 1.f)) { if (hi == 0) al_l[r32] = (a); asm volatile("s_waitcnt lgkmcnt(0)" ::: "memory"); \
    for (int d = 0; d < 4; ++d) for (int r = 0; r < 16; ++r) o[d][r] *= al_l[crow(r, hi)]; } } while (0)
  f32x16 pA0, pA1, pB0, pB1; float mnA, mnB, alA, alB; bf16x8 pa0, pa1, pa2, pa3; const int NT = seq / KVBLK;
  constexpr int SE = 0, SO = SDEPTH - 1;
  SLOAD(SE, 0); asm volatile("s_waitcnt vmcnt(0)" ::: "memory"); SWRITE(0, SE); __syncthreads();
  qkt(pA0, pA1, K_lds, qr, r32, hi); partialSM(pA0, pA1, m_reg, mnA, alA);
  SLOAD(SO, KVBLK); if constexpr (SDEPTH == 2) { if (2 < NT) SLOAD(SE, 2 * KVBLK); }
  SWAIT(); SWRITE(1, SO); __syncthreads();
  for (int j = 1; j + 1 < NT; j += 2) {
    SBAR(); qkt(pB0, pB1, (bf16*)((char*)K_lds + SHM_K), qr, r32, hi);
    finishSM(pA0, pA1, alA, l_reg, pa0, pa1, pa2, pa3); SBAR();
    SLOAD(SO, (j + SDEPTH) * KVBLK); SBAR();
    pv_d0(o, vb0, pa0, pa1, pa2, pa3); partialSM(pB0, pB1, m_reg, mnB, alB);
    __syncthreads(); SWAIT(); SWRITE(0, SE);
    RESC(alB); __syncthreads();
    SBAR(); qkt(pA0, pA1, K_lds, qr, r32, hi);
    finishSM(pB0, pB1, alB, l_reg, pa0, pa1, pa2, pa3); SBAR();
    if (SDEPTH == 1 || j + 3 < NT) SLOAD(SE, (j + 1 + SDEPTH) * KVBLK); SBAR();
    pv_d0(o, vb0 + (int)SHM_V, pa0, pa1, pa2, pa3); partialSM(pA0, pA1, m_reg, mnA, alA);
    __syncthreads(); SWAIT(); SWRITE(1, SO);
    RESC(alA); __syncthreads();
  }
  SBAR(); qkt(pB0, pB1, (bf16*)((char*)K_lds + SHM_K), qr, r32, hi);
  finishSM(pA0, pA1, alA, l_reg, pa0, pa1, pa2, pa3); SBAR();
  pv_d0(o, vb0, pa0, pa1, pa2, pa3); partialSM(pB0, pB1, m_reg, mnB, alB);
  __syncthreads(); RESC(alB);
  finishSM(pB0, pB1, alB, l_reg, pa0, pa1, pa2, pa3); SBAR();
  pv_d0(o, vb0 + (int)SHM_V, pa0, pa1, pa2, pa3);
  if (hi == 0) li_l[r32] = l_reg; asm volatile("s_waitcnt lgkmcnt(0)" ::: "memory");
  float rli[16];
#pragma unroll
  for (int r = 0; r < 16; ++r) rli[r] = __builtin_amdgcn_rcpf(li_l[crow(r, hi)]);
  float* Ow = Ob + (long)(wid * QBLK) * LDO;
#pragma unroll
  for (int r = 0; r < 16; ++r) { int orow = crow(r, hi);
    for (int d0 = 0; d0 < 4; ++d0) Ow[(long)orow * LDO + d0 * 32 + r32] = o[d0][r] * rli[r]; }
#undef SLOAD
#undef SWRITE
#undef SWAIT
#undef RESC
}

}
namespace att9 {
using bf16 = __hip_bfloat16;
using att::bf16x8; using att::s16x4; using att::f32x16; using att::u32x4; using att::crow; using att::cvtpk; using att::v_rd_base; using att::tr_read;
constexpr int   D = 128, DV = 256, NW = 8, QBLK = 32, KVBLK = 32;
constexpr float SCALE = 0.088388347648318440f;
constexpr float THR = 8.f;
constexpr int LDQ = 12288, LDK = 12288, LDO = 2048;
constexpr size_t SHM_V = KVBLK * DV * 2, SHM_K = KVBLK * D * 2, SHM_ATTN = 4 * SHM_V + 4 * SHM_K + NW * 64 * 4;
__device__ __forceinline__ void partialSM(f32x16& p0, float& m_reg, float& mn, float& alpha) {
  constexpr float C = SCALE * 1.4426950408889634f;
  float pmax = p0[0]; for (int r = 1; r < 16; ++r) pmax = fmaxf(pmax, p0[r]);
  { auto rr = __builtin_amdgcn_permlane32_swap(__float_as_uint(pmax), __float_as_uint(pmax), false, false);
    pmax = fmaxf(__uint_as_float(rr[0]), __uint_as_float(rr[1])); }
  if (__builtin_expect(__all(pmax - m_reg <= THR / SCALE), 1)) { mn = m_reg; alpha = 1.f; }
  else { mn = fmaxf(m_reg, pmax); alpha = __builtin_amdgcn_exp2f((m_reg - mn) * C); m_reg = mn; }
  float mnC = -mn * C;
  for (int r = 0; r < 16; ++r) p0[r] = fmaf(p0[r], C, mnC);
  for (int r = 0; r < 8; ++r) p0[r] = __builtin_amdgcn_exp2f(p0[r]);
}
__device__ __forceinline__ void finishSM(f32x16& p0, float alpha, float& l_reg, bf16x8& pa0, bf16x8& pa1) {
  for (int r = 8; r < 16; ++r) p0[r] = __builtin_amdgcn_exp2f(p0[r]);
  float ps = 0; for (int r = 0; r < 16; ++r) ps += p0[r];
  { auto rr = __builtin_amdgcn_permlane32_swap(__float_as_uint(ps), __float_as_uint(ps), false, false);
    ps = __uint_as_float(rr[0]) + __uint_as_float(rr[1]); }
  l_reg = l_reg * alpha + ps;
#define PK4(P, BASE, OUT) do { unsigned a0 = cvtpk(P[BASE + 0], P[BASE + 1]), a1 = cvtpk(P[BASE + 2], P[BASE + 3]);   \
    unsigned b0 = cvtpk(P[BASE + 4], P[BASE + 5]), b1 = cvtpk(P[BASE + 6], P[BASE + 7]);                              \
    auto r0 = __builtin_amdgcn_permlane32_swap(a0, b0, false, false); auto r1 = __builtin_amdgcn_permlane32_swap(a1, b1, false, false); \
    u32x4 w = {r0[0], r1[0], r0[1], r1[1]}; OUT = *reinterpret_cast<bf16x8*>(&w); } while (0)
  PK4(p0, 0, pa0); PK4(p0, 8, pa1);
#undef PK4
}
__device__ __forceinline__ void qkt(f32x16& p0, const bf16* Ks, const bf16x8* qr, int r32, int hi) {
  p0 = f32x16{};
  int swz = ((r32 & 15) << 4) ^ (hi << 4); asm volatile("" : "+v"(swz));
  const char* kr = (const char*)Ks + r32 * 256;
  for (int d0 = 0; d0 < 8; ++d0) {
    bf16x8 b0 = *reinterpret_cast<const bf16x8*>(kr + ((d0 * 32) ^ swz));
    p0 = __builtin_amdgcn_mfma_f32_32x32x16_bf16(b0, qr[d0], p0, 0, 0, 0); }
}
__device__ __forceinline__ int v_st(int k, int c) { const int kk = (k & ~0xC) | ((k & 4) << 1) | ((k & 8) >> 1); return ((kk >> 3) * 8 + (c >> 5)) * 512 + ((kk & 7) * 32 + (c & 31)) * 2; }
constexpr int v_rd_off(int d0, int ks, int half) { return d0 * 512 + (2 * ks + half) * 4096; }
template <int D0> __device__ __forceinline__ void pv_two(f32x16& oa, f32x16& ob, int vb, bf16x8 pa0, bf16x8 pa1) {
  const s16x4 l0 = tr_read<v_rd_off(D0, 0, 0)>(vb), h0 = tr_read<v_rd_off(D0, 0, 1)>(vb), l1 = tr_read<v_rd_off(D0, 1, 0)>(vb), h1 = tr_read<v_rd_off(D0, 1, 1)>(vb);
  const s16x4 l2 = tr_read<v_rd_off(D0 + 1, 0, 0)>(vb), h2 = tr_read<v_rd_off(D0 + 1, 0, 1)>(vb), l3 = tr_read<v_rd_off(D0 + 1, 1, 0)>(vb), h3 = tr_read<v_rd_off(D0 + 1, 1, 1)>(vb);
  asm volatile("s_waitcnt lgkmcnt(0)" ::: "memory"); SBAR();
#define PK(L, H) (bf16x8){L[0], L[1], L[2], L[3], H[0], H[1], H[2], H[3]}
  oa = __builtin_amdgcn_mfma_f32_32x32x16_bf16(pa0, PK(l0, h0), oa, 0, 0, 0);
  ob = __builtin_amdgcn_mfma_f32_32x32x16_bf16(pa0, PK(l2, h2), ob, 0, 0, 0);
  oa = __builtin_amdgcn_mfma_f32_32x32x16_bf16(pa1, PK(l1, h1), oa, 0, 0, 0);
  ob = __builtin_amdgcn_mfma_f32_32x32x16_bf16(pa1, PK(l3, h3), ob, 0, 0, 0);
#undef PK
}
template <int D0> __device__ __forceinline__ void pv_one(f32x16& oa, int vb, bf16x8 pa0, bf16x8 pa1) {
  const s16x4 l0 = tr_read<v_rd_off(D0, 0, 0)>(vb), h0 = tr_read<v_rd_off(D0, 0, 1)>(vb), l1 = tr_read<v_rd_off(D0, 1, 0)>(vb), h1 = tr_read<v_rd_off(D0, 1, 1)>(vb);
  asm volatile("s_waitcnt lgkmcnt(0)" ::: "memory"); SBAR();
#define PK(L, H) (bf16x8){L[0], L[1], L[2], L[3], H[0], H[1], H[2], H[3]}
  oa = __builtin_amdgcn_mfma_f32_32x32x16_bf16(pa0, PK(l0, h0), oa, 0, 0, 0);
  oa = __builtin_amdgcn_mfma_f32_32x32x16_bf16(pa1, PK(l1, h1), oa, 0, 0, 0);
#undef PK
}
__device__ __forceinline__ void pv_all(f32x16* o, int vb, bf16x8 pa0, bf16x8 pa1) {
  pv_two<0>(o[0], o[1], vb, pa0, pa1); pv_two<2>(o[2], o[3], vb, pa0, pa1); pv_two<4>(o[4], o[5], vb, pa0, pa1); pv_two<6>(o[6], o[7], vb, pa0, pa1);
}
__device__ __forceinline__ void attn_body(const int MODE, const bf16* __restrict__ Qb, const bf16* __restrict__ Kh, const bf16* __restrict__ Vh, float* Ob, unsigned short* Yb,
                                                              float lam, const float* subg, int seq, char* lds) {
  int tid_ = threadIdx.x; asm volatile("" : "+v"(tid_));
  const int tid = tid_, wid = tid >> 6, lane = tid & 63, r32 = lane & 31, hi = lane >> 5;
  bf16* V_lds = (bf16*)lds; bf16* K_lds = (bf16*)(lds + 4 * SHM_V);
  float* ws = (float*)(lds + 4 * SHM_V + 4 * SHM_K) + wid * 64; float* li_l = ws; float* al_l = ws + 32;
  float m_reg = -1e30f, l_reg = 0; f32x16 o[8] = {}; bf16x8 qr[8];
  const bf16* Qw = Qb + (long)(wid * QBLK + r32) * LDQ + hi * 8;
#pragma unroll
  for (int d0 = 0; d0 < 8; ++d0) qr[d0] = *reinterpret_cast<const bf16x8*>(Qw + d0 * 16);
  const int vb0 = (int)(uintptr_t)V_lds + v_rd_base(lane);
  const int krow = 4 * wid + (lane >> 4), gK = (krow * LDK) * 2 + (((lane & 15) ^ (krow & 15)) << 4);
  int gV[2];
#pragma unroll
  for (int q = 0; q < 2; ++q) { const int S = 2 * (2 * wid + q) + (lane >> 5), kk = (S >> 3) * 8 + ((lane & 31) >> 2), key = (kk & ~0xC) | ((kk & 4) << 1) | ((kk & 8) >> 1);
    gV[q] = (key * LDK + (S & 7) * 32 + (lane & 3) * 8) * 2; }
  typedef __attribute__((address_space(3))) unsigned lds_u32;
  const unsigned ldsK = (unsigned)(uintptr_t)K_lds + (unsigned)wid * 1024u, ldsV = (unsigned)(uintptr_t)V_lds + (unsigned)wid * 2048u;
#define DMA(k0, slot) do { const long to_ = (long)(k0) * (LDK * 2); const unsigned so_ = (unsigned)(slot); \
    __builtin_amdgcn_global_load_lds((const unsigned*)((const char*)Kh + to_ + gK), (lds_u32*)(uintptr_t)(ldsK + so_ * (unsigned)SHM_K), 16, 0, 0); \
    __builtin_amdgcn_global_load_lds((const unsigned*)((const char*)Vh + to_ + gV[0]), (lds_u32*)(uintptr_t)(ldsV + so_ * (unsigned)SHM_V), 16, 0, 0); \
    __builtin_amdgcn_global_load_lds((const unsigned*)((const char*)Vh + to_ + gV[1]), (lds_u32*)(uintptr_t)(ldsV + so_ * (unsigned)SHM_V + 1024u), 16, 0, 0); } while (0)
#define BAR_AFTER(N) do { asm volatile("s_waitcnt vmcnt(" #N ")" ::: "memory"); __builtin_amdgcn_s_barrier(); asm volatile("" ::: "memory"); SBAR(); } while (0)
#define RESC(a) do { if (__any((a) < 1.f)) { if (hi == 0) al_l[r32] = (a); asm volatile("s_waitcnt lgkmcnt(0)" ::: "memory"); \
    _Pragma("unroll") for (int rg = 0; rg < 4; ++rg) { const float a0_ = al_l[crow(4 * rg, hi)], a1_ = al_l[crow(4 * rg + 1, hi)], a2_ = al_l[crow(4 * rg + 2, hi)], a3_ = al_l[crow(4 * rg + 3, hi)]; \
      _Pragma("unroll") for (int d = 0; d < 8; ++d) { o[d][4 * rg] *= a0_; o[d][4 * rg + 1] *= a1_; o[d][4 * rg + 2] *= a2_; o[d][4 * rg + 3] *= a3_; } asm volatile("" ::: "memory"); } } } while (0)
  f32x16 pA, pB; float mnA, mnB, alA, alB; bf16x8 pa0, pa1; const int NT = seq / KVBLK;
  if (wid >= 4) __builtin_amdgcn_s_setprio(1);
  DMA(0, 0); DMA(KVBLK, 1); BAR_AFTER(0);
  qkt(pA, K_lds, qr, r32, hi); partialSM(pA, m_reg, mnA, alA);
  DMA(2 * KVBLK, 2);
  for (int j = 1; j + 1 < NT; j += 2) {
    DMA((j + 2) * KVBLK, (j + 2) & 3); SBAR();
    qkt(pB, (bf16*)((char*)K_lds + (j & 3) * SHM_K), qr, r32, hi);
    finishSM(pA, alA, l_reg, pa0, pa1); SBAR();
    pv_all(o, vb0 + ((j - 1) & 3) * (int)SHM_V, pa0, pa1); partialSM(pB, m_reg, mnB, alB);
    RESC(alB); BAR_AFTER(3);
    if (j + 3 < NT) { DMA((j + 3) * KVBLK, (j + 3) & 3); } SBAR();
    qkt(pA, (bf16*)((char*)K_lds + ((j + 1) & 3) * SHM_K), qr, r32, hi);
    finishSM(pB, alB, l_reg, pa0, pa1); SBAR();
    pv_all(o, vb0 + (j & 3) * (int)SHM_V, pa0, pa1); partialSM(pA, m_reg, mnA, alA);
    RESC(alA);
    if (j + 3 < NT) BAR_AFTER(3); else BAR_AFTER(0);
  }
  SBAR(); qkt(pB, (bf16*)((char*)K_lds + ((NT - 1) & 3) * SHM_K), qr, r32, hi);
  finishSM(pA, alA, l_reg, pa0, pa1); SBAR();
  pv_all(o, vb0 + ((NT - 2) & 3) * (int)SHM_V, pa0, pa1); partialSM(pB, m_reg, mnB, alB);
  RESC(alB);
  finishSM(pB, alB, l_reg, pa0, pa1); SBAR();
  pv_all(o, vb0 + ((NT - 1) & 3) * (int)SHM_V, pa0, pa1);
  __builtin_amdgcn_s_setprio(0);
  if (hi == 0) li_l[r32] = l_reg; asm volatile("s_waitcnt lgkmcnt(0)" ::: "memory");
  int lo_ = tid; asm volatile("" : "+v"(lo_));
  float rl[16];
#pragma unroll
  for (int r = 0; r < 16; ++r) rl[r] = __builtin_amdgcn_rcpf(li_l[crow(r, hi)]);
  if (MODE == 0) {
    __attribute__((address_space(1))) att::f32x4v* sp = (__attribute__((address_space(1))) att::f32x4v*)Ob + lo_;
#pragma unroll
    for (int g = 0; g < 32; ++g) { const int d0 = g >> 2, q = g & 3;
      *sp = (att::f32x4v){o[d0][4 * q] * rl[4 * q], o[d0][4 * q + 1] * rl[4 * q + 1], o[d0][4 * q + 2] * rl[4 * q + 2], o[d0][4 * q + 3] * rl[4 * q + 3]};
      sp += 512; asm volatile("" : "+v"(sp)); }
  } else {
    float ss[16];
#pragma unroll
    for (int r = 0; r < 16; ++r) { ss[r] = 0.f; rl[r] *= lam; }
    { const __attribute__((address_space(1))) att::f32x4v* sp = (const __attribute__((address_space(1))) att::f32x4v*)Ob + lo_;
#pragma unroll
      for (int g = 0; g < 32; ++g) { const int d0 = g >> 2, q = g & 3; const att::f32x4v a4 = *sp; sp += 512; asm volatile("" : "+v"(sp));
#pragma unroll
        for (int i = 0; i < 4; ++i) { const float d = a4[i] - o[d0][4 * q + i] * rl[4 * q + i]; ss[4 * q + i] += d * d; }
        if ((g & 7) == 7) asm volatile("" ::: "memory"); } }
#pragma unroll
    for (int r = 0; r < 16; ++r) {
#pragma unroll
      for (int off = 1; off < 32; off <<= 1) ss[r] += __shfl_xor(ss[r], off);
      ss[r] = 0.8f / sqrtf(ss[r] * (1.0f / 256.0f) + 1e-5f); }
    float gs[8];
#pragma unroll
    for (int d0 = 0; d0 < 8; ++d0) gs[d0] = subg[d0 * 32 + (lo_ & 31)];
    unsigned short* Yw = Yb + (long)(wid * QBLK + 4 * ((lo_ >> 5) & 1)) * 4096 + (lo_ & 31);
    { const __attribute__((address_space(1))) att::f32x4v* sp = (const __attribute__((address_space(1))) att::f32x4v*)Ob + lo_;
#pragma unroll
      for (int g = 0; g < 32; ++g) { const int d0 = g >> 2, q = g & 3; const att::f32x4v a4 = *sp; sp += 512; asm volatile("" : "+v"(sp));
#pragma unroll
        for (int i = 0; i < 4; ++i) { const int r = 4 * q + i; const float y = (a4[i] - o[d0][r] * rl[r]) * ss[r] * gs[d0];
          unsigned u = __float_as_uint(y); u = (u + 0x7fffu + ((u >> 16) & 1u)) >> 16; Yw[((r & 3) + 8 * (r >> 2)) * 4096 + d0 * 32] = (unsigned short)u; }
        if ((g & 7) == 7) asm volatile("" ::: "memory"); } }
  }
#undef DMA
#undef BAR_AFTER
#undef RESC
}
}
namespace att16 {
using bf16 = __hip_bfloat16;
using att::bf16x8; using att::s16x4; using att::u32x4; using att::cvtpk; using att::tr_read;
typedef float f32x4 __attribute__((ext_vector_type(4)));
constexpr int   D = 128, DV = 256, NW = 8, QBLK = 32, KVBLK = 32;
constexpr float SCALE = 0.088388347648318440f;
constexpr float THR = 8.f;
constexpr int LDQ = 12288, LDK = 12288;
constexpr size_t SHM_V = KVBLK * DV * 2, SHM_K = KVBLK * D * 2, SHM_ATTN = 4 * SHM_V + 4 * SHM_K;
#define MF16(A, B, C) __builtin_amdgcn_mfma_f32_16x16x32_bf16(A, B, C, 0, 0, 0)
__device__ __forceinline__ float vmax3(float a, float b, float c) { float r; asm("v_max3_f32 %0, %1, %2, %3" : "=v"(r) : "v"(a), "v"(b), "v"(c)); return r; }
__device__ __forceinline__ float vmax2(float a, float b) { float r; asm("v_max_f32 %0, %1, %2" : "=v"(r) : "v"(a), "v"(b)); return r; }
__device__ __forceinline__ float max8(const f32x4& a, const f32x4& b) { return vmax2(vmax3(vmax3(vmax3(a[0], a[1], a[2]), a[3], b[0]), b[1], b[2]), b[3]); }
__device__ __forceinline__ float max8c(const f32x4& a, const f32x4& b) { return fmaxf(fmaxf(fmaxf(a[0], a[1]), fmaxf(a[2], a[3])), fmaxf(fmaxf(b[0], b[1]), fmaxf(b[2], b[3]))); }
template <bool FRESH = false> __device__ __forceinline__ void partialSM(f32x4 (&s)[2][2], float (&m_reg)[2], float (&l_reg)[2], f32x4 (&o)[2][16]) {
  constexpr float C = SCALE * 1.4426950408889634f;
  float pm0 = FRESH ? max8c(s[0][0], s[1][0]) : max8(s[0][0], s[1][0]), pm1 = FRESH ? max8c(s[0][1], s[1][1]) : max8(s[0][1], s[1][1]);
  if (__builtin_expect(!__all((pm0 - m_reg[0] <= THR / SCALE) && (pm1 - m_reg[1] <= THR / SCALE)), 0)) {
    pm0 = fmaxf(pm0, __shfl_xor(pm0, 16)); pm0 = fmaxf(pm0, __shfl_xor(pm0, 32)); pm1 = fmaxf(pm1, __shfl_xor(pm1, 16)); pm1 = fmaxf(pm1, __shfl_xor(pm1, 32));
    const float n0 = fmaxf(m_reg[0], pm0), a0 = __builtin_amdgcn_exp2f((m_reg[0] - n0) * C), n1 = fmaxf(m_reg[1], pm1), a1 = __builtin_amdgcn_exp2f((m_reg[1] - n1) * C);
    m_reg[0] = n0; m_reg[1] = n1; l_reg[0] *= a0; l_reg[1] *= a1;
#pragma unroll
    for (int dt = 0; dt < 16; ++dt) { o[0][dt] *= a0; o[1][dt] *= a1; } }
  const float c0 = -m_reg[0] * C, c1 = -m_reg[1] * C;
#pragma unroll
  for (int t = 0; t < 2; ++t)
#pragma unroll
    for (int i = 0; i < 4; ++i) { s[t][0][i] = fmaf(s[t][0][i], C, c0); s[t][1][i] = fmaf(s[t][1][i], C, c1); }
#pragma unroll
  for (int i = 0; i < 4; ++i) { s[0][0][i] = __builtin_amdgcn_exp2f(s[0][0][i]); s[0][1][i] = __builtin_amdgcn_exp2f(s[0][1][i]); }
}
__device__ __forceinline__ void finishSM(f32x4 (&s)[2][2], float (&l_reg)[2], bf16x8 (&pf)[2]) {
#pragma unroll
  for (int i = 0; i < 4; ++i) { s[1][0][i] = __builtin_amdgcn_exp2f(s[1][0][i]); s[1][1][i] = __builtin_amdgcn_exp2f(s[1][1][i]); }
#pragma unroll
  for (int u = 0; u < 2; ++u) {
    const float ps = ((s[0][u][0] + s[0][u][1]) + (s[0][u][2] + s[0][u][3])) + ((s[1][u][0] + s[1][u][1]) + (s[1][u][2] + s[1][u][3]));
    l_reg[u] += ps;
    u32x4 w = {cvtpk(s[0][u][0], s[0][u][1]), cvtpk(s[0][u][2], s[0][u][3]), cvtpk(s[1][u][0], s[1][u][1]), cvtpk(s[1][u][2], s[1][u][3])}; pf[u] = *reinterpret_cast<bf16x8*>(&w); }
}
__device__ __forceinline__ void qkt(f32x4 (&s)[2][2], const bf16* Ks, const bf16x8 (&qr)[2][4], int j16, int g) {
  s[0][0] = f32x4{}; s[0][1] = f32x4{}; s[1][0] = f32x4{}; s[1][1] = f32x4{};
  int swz = (g ^ j16) << 4; asm volatile("" : "+v"(swz));
  const char* kr = (const char*)Ks + j16 * 256;
#pragma unroll
  for (int db = 0; db < 4; ++db) { const int x = (db * 64) ^ swz;
    const bf16x8 k0 = *reinterpret_cast<const bf16x8*>(kr + x), k1 = *reinterpret_cast<const bf16x8*>(kr + 4096 + x);
    s[0][0] = MF16(k0, qr[0][db], s[0][0]); s[0][1] = MF16(k0, qr[1][db], s[0][1]);
    s[1][0] = MF16(k1, qr[0][db], s[1][0]); s[1][1] = MF16(k1, qr[1][db], s[1][1]); }
}
constexpr int v_off(int dt, int t) { return (dt >> 1) * 2048 + t * 1024; }
#define PK(L, H) (bf16x8){L[0], L[1], L[2], L[3], H[0], H[1], H[2], H[3]}
template <int DT0> __device__ __forceinline__ void pv_grp(f32x4 (&o)[2][16], int vbE, int vbO, const bf16x8 (&pf)[2]) {
  const s16x4 a0 = tr_read<v_off(DT0, 0)>(vbE), a1 = tr_read<v_off(DT0, 1)>(vbE), b0 = tr_read<v_off(DT0 + 1, 0)>(vbO), b1 = tr_read<v_off(DT0 + 1, 1)>(vbO);
  const s16x4 c0 = tr_read<v_off(DT0 + 2, 0)>(vbE), c1 = tr_read<v_off(DT0 + 2, 1)>(vbE), d0 = tr_read<v_off(DT0 + 3, 0)>(vbO), d1 = tr_read<v_off(DT0 + 3, 1)>(vbO);
  asm volatile("s_waitcnt lgkmcnt(0)" ::: "memory"); SBAR();
  { const bf16x8 v = PK(a0, a1); o[0][DT0] = MF16(v, pf[0], o[0][DT0]); o[1][DT0] = MF16(v, pf[1], o[1][DT0]); }
  { const bf16x8 v = PK(b0, b1); o[0][DT0 + 1] = MF16(v, pf[0], o[0][DT0 + 1]); o[1][DT0 + 1] = MF16(v, pf[1], o[1][DT0 + 1]); }
  { const bf16x8 v = PK(c0, c1); o[0][DT0 + 2] = MF16(v, pf[0], o[0][DT0 + 2]); o[1][DT0 + 2] = MF16(v, pf[1], o[1][DT0 + 2]); }
  { const bf16x8 v = PK(d0, d1); o[0][DT0 + 3] = MF16(v, pf[0], o[0][DT0 + 3]); o[1][DT0 + 3] = MF16(v, pf[1], o[1][DT0 + 3]); }
}
#undef PK
__device__ __forceinline__ void pv_all(f32x4 (&o)[2][16], int vbE, const bf16x8 (&pf)[2]) {
  int vbO = vbE ^ 32; asm volatile("" : "+v"(vbO));
  pv_grp<0>(o, vbE, vbO, pf); pv_grp<4>(o, vbE, vbO, pf); pv_grp<8>(o, vbE, vbO, pf); pv_grp<12>(o, vbE, vbO, pf);
}
template <int OFF> __device__ __forceinline__ bf16x8 k_read(int ka) { bf16x8 r; asm volatile("ds_read_b128 %0, %1 offset:%2" : "=&v"(r) : "v"(ka), "i"(OFF) : "memory"); return r; }
__device__ __forceinline__ void k_load(bf16x8 (&kf)[2][4], int kb, int j16, int g) {
  int swz = (g ^ j16) << 4; asm volatile("" : "+v"(swz));
  const int kr = kb + j16 * 256;
  { const int a = kr + (0 ^ swz);   kf[0][0] = k_read<0>(a); kf[1][0] = k_read<4096>(a); }
  { const int a = kr + (64 ^ swz);  kf[0][1] = k_read<0>(a); kf[1][1] = k_read<4096>(a); }
  { const int a = kr + (128 ^ swz); kf[0][2] = k_read<0>(a); kf[1][2] = k_read<4096>(a); }
  { const int a = kr + (192 ^ swz); kf[0][3] = k_read<0>(a); kf[1][3] = k_read<4096>(a); }
}
__device__ __forceinline__ void qk_mma(f32x4 (&s)[2][2], const bf16x8 (&kf)[2][4], const bf16x8 (&qr)[2][4]) {
  s[0][0] = f32x4{}; s[0][1] = f32x4{}; s[1][0] = f32x4{}; s[1][1] = f32x4{};
#pragma unroll
  for (int db = 0; db < 4; ++db) {
    s[0][0] = MF16(kf[0][db], qr[0][db], s[0][0]); s[0][1] = MF16(kf[0][db], qr[1][db], s[0][1]);
    s[1][0] = MF16(kf[1][db], qr[0][db], s[1][0]); s[1][1] = MF16(kf[1][db], qr[1][db], s[1][1]); }
}
template <int DT0> __device__ __forceinline__ void pv_rd(int vbE, int vbO, s16x4 (&f)[8]) {
  f[0] = tr_read<v_off(DT0, 0)>(vbE); f[1] = tr_read<v_off(DT0, 1)>(vbE); f[2] = tr_read<v_off(DT0 + 1, 0)>(vbO); f[3] = tr_read<v_off(DT0 + 1, 1)>(vbO);
  f[4] = tr_read<v_off(DT0 + 2, 0)>(vbE); f[5] = tr_read<v_off(DT0 + 2, 1)>(vbE); f[6] = tr_read<v_off(DT0 + 3, 0)>(vbO); f[7] = tr_read<v_off(DT0 + 3, 1)>(vbO);
}
#define PK(L, H) (bf16x8){L[0], L[1], L[2], L[3], H[0], H[1], H[2], H[3]}
template <int DT0> __device__ __forceinline__ void pv_mm(f32x4 (&o)[2][16], const s16x4 (&f)[8], const bf16x8 (&pf)[2]) {
#pragma unroll
  for (int i = 0; i < 4; ++i) { const bf16x8 v = PK(f[2 * i], f[2 * i + 1]); o[0][DT0 + i] = MF16(v, pf[0], o[0][DT0 + i]); o[1][DT0 + i] = MF16(v, pf[1], o[1][DT0 + i]); }
}
#undef PK
__device__ __forceinline__ void attn_body(const int MODE, const bf16* __restrict__ Qb, const bf16* __restrict__ Kh, const bf16* __restrict__ Vh, float* Ob, unsigned short* Yb,
                                          float lam, const float* subg, int seq, char* lds) {
  int tid_ = threadIdx.x; asm volatile("" : "+v"(tid_));
  const int tid = tid_, wid = tid >> 6, lane = tid & 63, j16 = lane & 15, g = lane >> 4;
  bf16* V_lds = (bf16*)lds; bf16* K_lds = (bf16*)(lds + 4 * SHM_V);
  float m_reg[2] = {-1e30f, -1e30f}, l_reg[2] = {0.f, 0.f}; f32x4 o[2][16]; bf16x8 qr[2][4];
#pragma unroll
  for (int u = 0; u < 2; ++u)
#pragma unroll
    for (int dt = 0; dt < 16; ++dt) o[u][dt] = f32x4{};
#pragma unroll
  for (int u = 0; u < 2; ++u)
#pragma unroll
    for (int db = 0; db < 4; ++db) qr[u][db] = *reinterpret_cast<const bf16x8*>(Qb + (long)(wid * QBLK + 16 * u + j16) * LDQ + db * 32 + g * 8);
  const int vrb = (4 * g + (j16 >> 2)) * 64 + 8 * (j16 & 3) + (g & 1) * 32;
  const int vbE0 = (int)(uintptr_t)V_lds + vrb;
  const int krow = 4 * wid + (lane >> 4), gK = (krow * LDK) * 2 + (((lane & 15) ^ (krow & 15)) << 4);
  const int gV0 = ((lane >> 2) * LDK + wid * 32 + ((((lane >> 1) ^ (lane >> 4)) & 1) * 16) + (lane & 1) * 8) * 2;
  typedef __attribute__((address_space(3))) unsigned lds_u32;
  const unsigned ldsK = (unsigned)(uintptr_t)K_lds + (unsigned)wid * 1024u, ldsV = (unsigned)(uintptr_t)V_lds + (unsigned)wid * 2048u;
#define DMA(k0, slot) do { const long to_ = (long)(k0) * (LDK * 2); const unsigned so_ = (unsigned)(slot); \
    __builtin_amdgcn_global_load_lds((const unsigned*)((const char*)Kh + to_ + gK), (lds_u32*)(uintptr_t)(ldsK + so_ * (unsigned)SHM_K), 16, 0, 0); \
    __builtin_amdgcn_global_load_lds((const unsigned*)((const char*)Vh + to_ + gV0), (lds_u32*)(uintptr_t)(ldsV + so_ * (unsigned)SHM_V), 16, 0, 0); \
    __builtin_amdgcn_global_load_lds((const unsigned*)((const char*)Vh + (to_ + 16L * LDK * 2) + gV0), (lds_u32*)(uintptr_t)(ldsV + so_ * (unsigned)SHM_V + 1024u), 16, 0, 0); } while (0)
#define BAR_AFTER(N) do { asm volatile("s_waitcnt vmcnt(" #N ")" ::: "memory"); __builtin_amdgcn_s_barrier(); asm volatile("" ::: "memory"); SBAR(); } while (0)
  f32x4 pA[2][2], pB[2][2]; bf16x8 pf[2]; const int NT = seq / KVBLK;
  if (wid >= 4) __builtin_amdgcn_s_setprio(1);
  DMA(0, 0); DMA(KVBLK, 1); BAR_AFTER(0);
  qkt(pA, K_lds, qr, j16, g); partialSM<true>(pA, m_reg, l_reg, o);
  DMA(2 * KVBLK, 2);
#define LWAIT() do { asm volatile("s_waitcnt lgkmcnt(0)" ::: "memory"); SBAR(); } while (0)
#define STEP(pN, pO, kslot, vslot) do { bf16x8 kf[2][4]; s16x4 fa[8], fb[8]; \
    k_load(kf, (int)(uintptr_t)K_lds + (kslot) * (int)SHM_K, j16, g); finishSM(pO, l_reg, pf); LWAIT(); \
    const int vE = vbE0 + (vslot) * (int)SHM_V; int vO = vE ^ 32; asm volatile("" : "+v"(vO)); \
    pv_rd<0>(vE, vO, fa); qk_mma(pN, kf, qr); LWAIT(); \
    pv_rd<4>(vE, vO, fb); pv_mm<0>(o, fa, pf); LWAIT(); \
    pv_rd<8>(vE, vO, fa); pv_mm<4>(o, fb, pf); LWAIT(); \
    pv_rd<12>(vE, vO, fb); pv_mm<8>(o, fa, pf); LWAIT(); \
    pv_mm<12>(o, fb, pf); partialSM(pN, m_reg, l_reg, o); } while (0)
  for (int j = 1; j + 1 < NT; j += 2) {
    DMA((j + 2) * KVBLK, (j + 2) & 3); SBAR();
    STEP(pB, pA, j & 3, (j - 1) & 3);
    BAR_AFTER(3);
    if (j + 3 < NT) { DMA((j + 3) * KVBLK, (j + 3) & 3); } SBAR();
    STEP(pA, pB, (j + 1) & 3, j & 3);
    if (j + 3 < NT) BAR_AFTER(3); else BAR_AFTER(0);
  }
  SBAR(); STEP(pB, pA, (NT - 1) & 3, (NT - 2) & 3);
  finishSM(pB, l_reg, pf); SBAR();
  pv_all(o, vbE0 + ((NT - 1) & 3) * (int)SHM_V, pf);
#undef STEP
#undef LWAIT
  __builtin_amdgcn_s_setprio(0);
  int lo_ = tid; asm volatile("" : "+v"(lo_));
  float rl[2];
#pragma unroll
  for (int u = 0; u < 2; ++u) { float x = l_reg[u]; x += __shfl_xor(x, 16); x += __shfl_xor(x, 32); rl[u] = __builtin_amdgcn_rcpf(x); }
  if (MODE == 0) {
    __attribute__((address_space(1))) f32x4* sp = (__attribute__((address_space(1))) f32x4*)Ob + lo_;
#pragma unroll
    for (int s = 0; s < 32; ++s) { const int u = s >> 4, dt = s & 15; *sp = o[u][dt] * rl[u]; sp += 512; asm volatile("" : "+v"(sp)); }
  } else {
    float ss[2] = {0.f, 0.f}; rl[0] *= lam; rl[1] *= lam;
    { const __attribute__((address_space(1))) f32x4* sp = (const __attribute__((address_space(1))) f32x4*)Ob + lo_;
#pragma unroll
      for (int s = 0; s < 32; ++s) { const int u = s >> 4, dt = s & 15; const f32x4 a4 = *sp; sp += 512; asm volatile("" : "+v"(sp));
#pragma unroll
        for (int i = 0; i < 4; ++i) { const float d = a4[i] - o[u][dt][i] * rl[u]; ss[u] += d * d; }
        if ((s & 7) == 7) asm volatile("" ::: "memory"); } }
#pragma unroll
    for (int u = 0; u < 2; ++u) { float x = ss[u]; x += __shfl_xor(x, 16); x += __shfl_xor(x, 32); ss[u] = 0.8f / sqrtf(x * (1.0f / 256.0f) + 1e-5f); }
    const int jj = lo_ & 15, gg = (lo_ >> 4) & 3;
    const float* gp = subg + 4 * gg;
    unsigned short* Yw = Yb + (long)((lo_ >> 6) * QBLK + jj) * 4096 + 4 * gg;
    { const __attribute__((address_space(1))) f32x4* sp = (const __attribute__((address_space(1))) f32x4*)Ob + lo_;
#pragma unroll
      for (int s = 0; s < 32; ++s) { const int u = s >> 4, dt = s & 15; const f32x4 a4 = *sp; sp += 512; asm volatile("" : "+v"(sp));
        const f32x4 g4 = *reinterpret_cast<const f32x4*>(gp + 16 * dt);
        float y[4];
#pragma unroll
        for (int i = 0; i < 4; ++i) y[i] = (a4[i] - o[u][dt][i] * rl[u]) * ss[u] * g4[i];
        uint2 w; w.x = cvtpk(y[0], y[1]); w.y = cvtpk(y[2], y[3]);
        *reinterpret_cast<uint2*>(Yw + (long)(16 * u) * 4096 + 16 * dt) = w;
        if ((s & 7) == 7) asm volatile("" ::: "memory"); } }
  }
#undef DMA
#undef BAR_AFTER
}
#undef MF16
}
namespace mk {
constexpr int NWAVES = 8, NTHR = NWAVES * 64;
constexpr int N_LAUNCHES = MK_N_LAUNCHES;
constexpr int PER_PHASE = 11;
constexpr int BATCH = 2, SEQ = 8192, DM = 4096, M = BATCH * SEQ, HYW = 2048, NIN = 12288, FFN = 11008, NGU = 2 * FFN, NMOD = 6 * DM, NHEAD = 8;
constexpr int QOFF = 3 * HYW, KOFF = QOFF + 2048, VOFF = KOFF + 2048;
constexpr int FFTN = 2 * SEQ;
constexpr float NORM_EPS = 1e-6f, SUBLN_EPS = 1e-5f, LAM_INIT = 0.2f;
constexpr size_t MiB = 1u << 20;
constexpr size_t WS_CTL = 0, CTL_ZERO_BYTES = 1 * MiB;
constexpr size_t WS_TW = 1 * MiB;
constexpr size_t WS_H3 = 2 * MiB;
constexpr size_t WS_ROPE = 4 * MiB;
constexpr size_t WS_WIN = 16 * MiB, WS_WOUT = 112 * MiB, WS_WGU = 144 * MiB, WS_WDN = 316 * MiB;
constexpr size_t WS_HA = 402 * MiB;
constexpr size_t WS_X0T = WS_HA, WS_YT = WS_HA + 64 * MiB;
constexpr size_t WS_PROJ = 530 * MiB;
constexpr size_t WS_ACT = WS_PROJ;
constexpr size_t WS_YMIX = 914 * MiB;
constexpr size_t WS_X1 = 1042 * MiB;
constexpr size_t WS_O0 = WS_X1, WS_O1 = WS_X1 + 128 * MiB;
constexpr size_t WS_KSPEC = 1298 * MiB;
constexpr size_t WS_KERN = 1170 * MiB;
constexpr size_t WS_VXT = 1330 * MiB;
constexpr size_t WS_X2 = 16 * MiB;
constexpr size_t WS_END = 1458 * MiB;
static_assert(WS_WIN + (size_t)NIN * DM * 2 <= WS_WOUT && WS_WOUT + (size_t)DM * DM * 2 <= WS_WGU && WS_WGU + (size_t)NGU * DM * 2 <= WS_WDN && WS_WDN + (size_t)DM * FFN * 2 <= WS_HA, "weights");
static_assert(WS_O0 + (size_t)M * 2048 * 4 <= WS_KERN && WS_KERN + (size_t)HYW * FFTN * 4 <= WS_KSPEC && WS_KSPEC + (size_t)256 * FFTN * 8 <= WS_VXT && WS_VXT + (size_t)HYW * 2 * SEQ * 4 <= WS_END && WS_X2 + (size_t)M * DM * 4 <= WS_WDN, "scratch");
static_assert(WS_HA + (size_t)M * DM * 2 <= WS_PROJ && WS_PROJ + (size_t)M * NIN * 2 <= WS_YMIX && WS_YMIX + (size_t)M * DM * 2 <= WS_X1 && WS_X1 + (size_t)M * DM * 4 <= WS_KSPEC, "activations");
constexpr int CW_TMO = 0, CW_CODE = 1, CW_LAM = 64;
constexpr int CW_XRANK = 1024;
constexpr int CW_BAR = 4096;
constexpr int CW_MOD = 16384;
static_assert((CW_MOD + 2 * NMOD) * 4 <= (int)CTL_ZERO_BYTES, "ctl");
constexpr int FFT_PHYS = FFTN + FFTN / 32;
constexpr int RING_BYTES = FFT_PHYS * 8;
constexpr int LDSCTL_OFF = RING_BYTES, MISC_OFF = LDSCTL_OFF + 320;
constexpr int LDS_BYTES = RING_BYTES + 1024;
static_assert(pg8::STAGE_BYTES <= RING_BYTES && att16::SHM_ATTN <= (size_t)RING_BYTES, "LDS map");

#define GAS __attribute__((address_space(1)))
#define LAS __attribute__((address_space(3)))
#define CAS __attribute__((address_space(4)))
typedef unsigned short bf16;
typedef unsigned v4u __attribute__((ext_vector_type(4)));
typedef unsigned v2u __attribute__((ext_vector_type(2)));
typedef float f32x4 __attribute__((ext_vector_type(4)));
typedef float f32x2 __attribute__((ext_vector_type(2)));
typedef float f32x8 __attribute__((ext_vector_type(8)));
typedef GAS unsigned gu32;
#define RLX_AGENT __ATOMIC_RELAXED, __HIP_MEMORY_SCOPE_AGENT
#define LDS_WAIT() asm volatile("s_waitcnt lgkmcnt(0)" ::: "memory")
#define VM_WAIT() asm volatile("s_waitcnt vmcnt(0)" ::: "memory")
__device__ __forceinline__ unsigned f2bf(float f) { unsigned u = __builtin_bit_cast(unsigned, f); return (u + 0x7fffu + ((u >> 16) & 1u)) >> 16; }
__device__ __forceinline__ unsigned pk2(float lo, float hi) { return f2bf(lo) | (f2bf(hi) << 16); }
__device__ __forceinline__ float bf2f(unsigned short b) { return __builtin_bit_cast(float, (unsigned)b << 16); }
__device__ __forceinline__ float bflo(unsigned w) { return __builtin_bit_cast(float, w << 16); }
__device__ __forceinline__ float bfhi(unsigned w) { return __builtin_bit_cast(float, w & 0xffff0000u); }

#define XB_TMO      128
#define XB_XCNT(j)  (256  + 64 * (j))
#define XB_XSUB(j)  (1280 + 64 * (j))
#define XB_XGEN(j)  (2304 + 64 * (j))
#define XB_TOP      3328
#define XB_TOPGEN   3392
#define XCD_BAR_WORDS 3456
#define XB_SPIN_CAP (1u << 18)

__device__ __forceinline__ unsigned xb_ld(unsigned* p)              { return __hip_atomic_load(p, __ATOMIC_RELAXED, __HIP_MEMORY_SCOPE_AGENT); }
__device__ __forceinline__ unsigned xb_add(unsigned* p, unsigned v) { return __hip_atomic_fetch_add(p, v, __ATOMIC_RELAXED, __HIP_MEMORY_SCOPE_AGENT); }
__device__ __forceinline__ unsigned xb_xcc_id() { return (unsigned)__builtin_amdgcn_s_getreg((3 << 11) | 20) & 0xFu; }
#define XB_SPIN(cond, bar) do { unsigned _sp = 0; while (cond) { __builtin_amdgcn_s_sleep(1); \
    if ((++_sp & 255u) == 0u) { if (xb_ld(&(bar)[XB_TMO])) break; if (_sp > XB_SPIN_CAP) { atomicAdd(&(bar)[XB_TMO], 1u); break; } } } } while (0)

struct XcdBarrier {
    unsigned* bar; unsigned x;
    volatile LAS unsigned* st;
};

__device__ __forceinline__ XcdBarrier xcd_barrier_post(unsigned* bar, volatile LAS unsigned* st) {
    XcdBarrier b; b.bar = bar; b.x = xb_xcc_id(); b.st = st;
    if (threadIdx.x == 0) (void)xb_add(&bar[XB_XCNT(b.x)], 1u);
    return b;
}
__device__ __forceinline__ void xcd_barrier_complete(unsigned* bar, unsigned x, unsigned& nloc, unsigned& nx) {
    const unsigned G = gridDim.x * gridDim.y * gridDim.z;
    unsigned sum, cnt, mine, sp = 0u;
    for (;;) {
        sum = 0u; cnt = 0u; mine = 0u;
#pragma unroll
        for (unsigned j = 0; j < 16; ++j) { const unsigned c = xb_ld(&bar[XB_XCNT(j)]); sum += c; cnt += (c > 0u) ? 1u : 0u; mine = (j == x) ? c : mine; }
        if (sum == G) break;
        __builtin_amdgcn_s_sleep(1);
        if ((++sp & 255u) == 0u) { if (xb_ld(&bar[XB_TMO])) break; if (sp > XB_SPIN_CAP) { atomicAdd(&bar[XB_TMO], 1u); break; } }
    }
    nloc = mine > 0u ? mine : 1u; nx = cnt > 0u ? cnt : 1u;
}

__device__ __forceinline__ void xcd_barrier(const XcdBarrier& b) {
    asm volatile("s_waitcnt vmcnt(0)" ::: "memory");
    __syncthreads();
    if (threadIdx.x == 0) {
        unsigned* bar = b.bar;
        __builtin_amdgcn_s_waitcnt(0);
        unsigned nloc = b.st[0], nx = b.st[1];
        if (nloc == 0u) { xcd_barrier_complete(bar, b.x, nloc, nx); b.st[0] = nloc; b.st[1] = nx; }
        const unsigned old = xb_add(&bar[XB_XSUB(b.x)], 1u);
        const unsigned gen = old / nloc;
        if (old + 1u == (gen + 1u) * nloc) {
            __builtin_amdgcn_fence(__ATOMIC_RELEASE, "agent");
            asm volatile("s_waitcnt vmcnt(0)" ::: "memory");
            const unsigned og = xb_add(&bar[XB_TOP], 1u);
            const unsigned tg = og / nx;
            if (og + 1u == (tg + 1u) * nx) xb_add(&bar[XB_TOPGEN], 1u);
            else XB_SPIN(xb_ld(&bar[XB_TOPGEN]) == tg, bar);
            __builtin_amdgcn_fence(__ATOMIC_ACQUIRE, "agent");
            xb_add(&bar[XB_XGEN(b.x)], 1u);
            asm volatile("s_waitcnt vmcnt(0)" ::: "memory");
        } else {
            XB_SPIN(xb_ld(&bar[XB_XGEN(b.x)]) == gen, bar);
            __builtin_amdgcn_fence(__ATOMIC_ACQUIRE, "agent");
            asm volatile("s_waitcnt vmcnt(0)" ::: "memory");
        }
    }
    __syncthreads();
}

__device__ __forceinline__ float wave_sum(float v) {
#pragma unroll
    for (int o = 1; o < 64; o <<= 1) v += __shfl_xor(v, o);
    return v;
}
__device__ __forceinline__ f32x2 cmul(f32x2 a, f32x2 b) { return (f32x2){a.x * b.x - a.y * b.y, a.x * b.y + a.y * b.x}; }
__device__ __forceinline__ f32x2 cmulc(f32x2 a, f32x2 b) { return (f32x2){a.x * b.x + a.y * b.y, a.y * b.x - a.x * b.y}; }

__device__ __forceinline__ void p0_transpose_item(const float* W, int N, int K, bf16* WT, int k0, int n0, int drow0, LAS float* scr, int lane) {
    f32x4 v[16];
    { const GAS f32x4* wp = (const GAS f32x4*)(W + (size_t)(k0 + (lane >> 4)) * N + n0 + 4 * (lane & 15));
#pragma unroll
      for (int i = 0; i < 16; ++i) { v[i] = *wp; wp += N; asm volatile("" : "+v"(wp)); } }
    __builtin_amdgcn_sched_barrier(0);
#pragma unroll
    for (int i = 0; i < 16; ++i) { const int kk = 4 * i + (lane >> 4); LAS float* d = scr + kk * 65 + 4 * (lane & 15); d[0] = v[i].x; d[1] = v[i].y; d[2] = v[i].z; d[3] = v[i].w; }
    LDS_WAIT(); asm volatile("" ::: "memory");
    const int c = lane & 7;
#pragma unroll
    for (int j = 0; j < 8; ++j) { const int n = (lane >> 3) + 8 * j; const LAS float* s = scr + (8 * c) * 65 + n;
        v4u o; o.x = pk2(s[0 * 65], s[1 * 65]); o.y = pk2(s[2 * 65], s[3 * 65]); o.z = pk2(s[4 * 65], s[5 * 65]); o.w = pk2(s[6 * 65], s[7 * 65]);
        *(GAS v4u*)(WT + (size_t)(drow0 + n) * K + k0 + 8 * c) = o; }
    LDS_WAIT(); asm volatile("" ::: "memory");
}
__device__ __forceinline__ void p0_weights(int gw, int NGW, int wave, int lane, LAS unsigned char* lds, const float* w_in, const float* w_out, const float* w_gate, const float* w_up,
                                           const float* w_down, bf16* WIN, bf16* WOUT, bf16* WGU, bf16* WDN) {
    LAS float* scr = (LAS float*)(lds + wave * 16640);
    constexpr int I_IN = (DM / 64) * (NIN / 64), I_OUT = (DM / 64) * (DM / 64), I_G = (DM / 64) * (FFN / 64), I_D = (FFN / 64) * (DM / 64);
    constexpr int NITEMS = I_IN + I_OUT + 2 * I_G + I_D;
    for (int it = gw; it < NITEMS; it += NGW) {
        int r = it;
        if (r < I_IN) { constexpr int nb = NIN / 64; const int kb = r / nb, n0 = (r % nb) * 64, blk = (n0 >> 6) & 3;
            const int dr = (n0 >= QOFF && n0 < VOFF) ? (blk == 1 ? n0 + 64 : (blk == 2 ? n0 - 64 : n0)) : n0;
            p0_transpose_item(w_in, NIN, DM, WIN, kb * 64, n0, dr, scr, lane); continue; } r -= I_IN;
        if (r < I_OUT) { constexpr int nb = DM / 64; const int kb = r / nb, n0 = (r % nb) * 64; p0_transpose_item(w_out, DM, DM, WOUT, kb * 64, n0, n0, scr, lane); continue; } r -= I_OUT;
        if (r < I_G) { constexpr int nb = FFN / 64; const int kb = r / nb, n0 = (r % nb) * 64; p0_transpose_item(w_gate, FFN, DM, WGU, kb * 64, n0, 256 * (n0 >> 7) + (n0 & 127), scr, lane); continue; } r -= I_G;
        if (r < I_G) { constexpr int nb = FFN / 64; const int kb = r / nb, n0 = (r % nb) * 64; p0_transpose_item(w_up, FFN, DM, WGU, kb * 64, n0, 256 * (n0 >> 7) + 128 + (n0 & 127), scr, lane); continue; } r -= I_G;
        { constexpr int nb = DM / 64; const int kb = r / nb, n0 = (r % nb) * 64; p0_transpose_item(w_down, DM, FFN, WDN, kb * 64, n0, n0, scr, lane); }
    }
}
__device__ __forceinline__ void p0_adaln(int gw, int NGW, int lane, const float* c, const float* w_ada, const float* b_ada, float* mod) {
    for (int it = gw; it < 64 * 96; it += NGW) {
        const int kc = it / 96, nc = it % 96, k0 = kc * 64, n0 = nc * 256 + 4 * lane;
        float cv0 = c[k0 + lane], cv1 = c[DM + k0 + lane];
        cv0 = cv0 / (1.0f + expf(-cv0)); cv1 = cv1 / (1.0f + expf(-cv1));
        f32x4 a0 = {0.f, 0.f, 0.f, 0.f}, a1 = {0.f, 0.f, 0.f, 0.f};
        const GAS f32x4* wp = (const GAS f32x4*)(w_ada + (size_t)k0 * NMOD + n0);
#pragma unroll 8
        for (int k = 0; k < 64; ++k) { const f32x4 w = wp[(size_t)k * (NMOD / 4)]; const float s0 = __shfl(cv0, k), s1 = __shfl(cv1, k); a0 += s0 * w; a1 += s1 * w; }
        if (kc == 0) { const f32x4 bv = *(const GAS f32x4*)(b_ada + n0); a0 += bv; a1 += bv; }
        float* m0 = mod + n0; float* m1 = mod + NMOD + n0;
        unsafeAtomicAdd(m0 + 0, a0.x); unsafeAtomicAdd(m0 + 1, a0.y); unsafeAtomicAdd(m0 + 2, a0.z); unsafeAtomicAdd(m0 + 3, a0.w);
        unsafeAtomicAdd(m1 + 0, a1.x); unsafeAtomicAdd(m1 + 1, a1.y); unsafeAtomicAdd(m1 + 2, a1.z); unsafeAtomicAdd(m1 + 3, a1.w);
    }
}
__device__ __forceinline__ void p0_filter_mlp(int gw, int NGW, int lane, const float* w1, const float* b1, const float* w2, const float* b2, const float* w3, const float* b3,
                                              const float* freq, float* h3) {
    const float fr = freq[lane], bb1 = b1[lane], bb2 = b2[lane], bb3 = b3[lane];
    for (int i = gw; i < SEQ; i += NGW) {
        const float ti = (float)i * (1.0f / (float)(SEQ - 1));
        const float wi = (6.283185307179586f * (float)i) / (float)SEQ;
        const int kf = (lane >= 17) ? lane - 17 : lane - 1;
        const float fk = 1e-4f + (float)(kf & 15) * ((15.0f - 1e-4f) / 15.0f), a = fk * wi;
        const float z = (lane == 0) ? ti : ((lane <= 16) ? cosf(a) : -sinf(a));
        float acc = bb1;
        for (int l = 0; l < 33; ++l) acc += __shfl(z, l) * w1[l * 64 + lane];
        float h = sinf(fr * acc);
        acc = bb2;
        for (int l = 0; l < 64; ++l) acc += __shfl(h, l) * w2[l * 64 + lane];
        h = sinf(fr * acc);
        acc = bb3;
        for (int l = 0; l < 64; ++l) acc += __shfl(h, l) * w3[l * 64 + lane];
        h = sinf(fr * acc);
        h3[(size_t)i * 64 + lane] = h;
    }
}
__device__ __forceinline__ void p0_tables(int gt, int NGT, const int* pos, f32x2* rope, f32x2* tw) {
    for (int idx = gt; idx < M * 64; idx += NGT) { const int m = idx >> 6, i = idx & 63;
        const float inv = 1.0f / powf(10000.0f, (float)(2 * i) * (1.0f / 128.0f)); const float ang = (float)pos[m] * inv;
        rope[idx] = (f32x2){cosf(ang), sinf(ang)}; }
    for (int p = gt; p < FFTN; p += NGT) { const float a = (float)p * (1.0f / (float)SEQ); tw[p] = (f32x2){cospif(a), -sinpif(a)}; }
}

#define ROWS_SBAR() __builtin_amdgcn_sched_barrier(0)
__device__ __forceinline__ void rms_mod_table(int tid, LAS unsigned char* lds, const float* g, const float* mod, int sh_off, int sc_off) {
    LAS float* La = (LAS float*)lds; LAS float* Ls = La + BATCH * DM;
    for (int i = tid; i < BATCH * DM; i += NTHR) { const int b = i / DM, col = i % DM; La[i] = g[col] * (1.0f + mod[(size_t)b * NMOD + sc_off + col]); Ls[i] = mod[(size_t)b * NMOD + sh_off + col]; }
}
__device__ __forceinline__ void rms_mod_rows(int gw, int NGW, int lane, LAS unsigned char* lds, const float* X, bf16* out) {
    LAS float* La = (LAS float*)lds; LAS float* Ls = La + BATCH * DM;
    for (int m = gw; m < M; m += NGW) {
        const GAS f32x4* xr = (const GAS f32x4*)(X + (size_t)m * DM) + lane;
        f32x4 v[16];
#pragma unroll
        for (int j = 0; j < 16; ++j) v[j] = xr[64 * j];
        ROWS_SBAR();
        float s = 0.f;
#pragma unroll
        for (int j = 0; j < 16; ++j) s += (v[j].x * v[j].x + v[j].y * v[j].y) + (v[j].z * v[j].z + v[j].w * v[j].w);
        const float rstd = 1.0f / sqrtf(wave_sum(s) * (1.f / DM) + NORM_EPS);
        const LAS f32x4* a = (const LAS f32x4*)(La + (m / SEQ) * DM) + lane; const LAS f32x4* sh = (const LAS f32x4*)(Ls + (m / SEQ) * DM) + lane;
        GAS v2u* o = (GAS v2u*)(out + (size_t)m * DM) + lane;
#pragma unroll
        for (int j = 0; j < 16; ++j) { const f32x4 y = (v[j] * rstd) * a[64 * j] + sh[64 * j]; o[64 * j] = (v2u){pk2(y.x, y.y), pk2(y.z, y.w)}; }
    }
}
__device__ __forceinline__ void rms_mod_rows_b16(int gw, int NGW, int lane, LAS unsigned char* lds, const bf16* X, bf16* out) {
    LAS float* La = (LAS float*)lds; LAS float* Ls = La + BATCH * DM;
    for (int m = gw; m < M; m += NGW) {
        const GAS v4u* xr = (const GAS v4u*)(X + (size_t)m * DM) + lane;
        v4u v[8];
#pragma unroll
        for (int j = 0; j < 8; ++j) v[j] = xr[64 * j];
        ROWS_SBAR();
        float s = 0.f;
#pragma unroll
        for (int j = 0; j < 8; ++j) {
#pragma unroll
            for (int q = 0; q < 4; ++q) { const float lo = bflo(v[j][q]), hi = bfhi(v[j][q]); s += lo * lo + hi * hi; } }
        const float rstd = 1.0f / sqrtf(wave_sum(s) * (1.f / DM) + NORM_EPS);
        const LAS f32x4* a = (const LAS f32x4*)(La + (m / SEQ) * DM) + 2 * lane; const LAS f32x4* sh = (const LAS f32x4*)(Ls + (m / SEQ) * DM) + 2 * lane;
        GAS v4u* o = (GAS v4u*)(out + (size_t)m * DM) + lane;
#pragma unroll
        for (int j = 0; j < 8; ++j) { const f32x4 a0 = a[128 * j], a1 = a[128 * j + 1], s0 = sh[128 * j], s1 = sh[128 * j + 1];
            const f32x4 x0 = (f32x4){bflo(v[j].x), bfhi(v[j].x), bflo(v[j].y), bfhi(v[j].y)}, x1 = (f32x4){bflo(v[j].z), bfhi(v[j].z), bflo(v[j].w), bfhi(v[j].w)};
            const f32x4 y0 = (x0 * rstd) * a0 + s0, y1 = (x1 * rstd) * a1 + s1;
            o[64 * j] = (v4u){pk2(y0.x, y0.y), pk2(y0.z, y0.w), pk2(y1.x, y1.y), pk2(y1.z, y1.w)}; }
    }
}
__device__ __forceinline__ void rms_final_rows_b16(int gw, int NGW, int lane, const bf16* X, float* out, const float* g) {
    f32x4 gg[16];
#pragma unroll
    for (int j = 0; j < 8; ++j) { gg[2 * j] = *(const GAS f32x4*)(g + 8 * lane + 512 * j); gg[2 * j + 1] = *(const GAS f32x4*)(g + 8 * lane + 512 * j + 4); }
    for (int m = gw; m < M; m += 2 * NGW) {
        const int m2 = m + NGW; const bool two = m2 < M;
        const GAS v4u* xr = (const GAS v4u*)(X + (size_t)m * DM) + lane; const GAS v4u* xr2 = (const GAS v4u*)(X + (size_t)(two ? m2 : m) * DM) + lane;
        v4u v[8], w[8];
#pragma unroll
        for (int j = 0; j < 8; ++j) v[j] = xr[64 * j];
#pragma unroll
        for (int j = 0; j < 8; ++j) w[j] = xr2[64 * j];
        ROWS_SBAR();
#pragma unroll
        for (int rr = 0; rr < 2; ++rr) {
            float s = 0.f;
#pragma unroll
            for (int j = 0; j < 8; ++j) {
#pragma unroll
                for (int q = 0; q < 4; ++q) { const unsigned u = rr ? w[j][q] : v[j][q]; const float lo = bflo(u), hi = bfhi(u); s += lo * lo + hi * hi; } }
            const float rstd = 1.0f / sqrtf(wave_sum(s) * (1.f / DM) + NORM_EPS);
            if (rr == 0 || two) { GAS f32x4* orow = (GAS f32x4*)(out + (size_t)(rr ? m2 : m) * DM) + 2 * lane;
#pragma unroll
                for (int j = 0; j < 8; ++j) { const v4u u = rr ? w[j] : v[j];
                    orow[128 * j] = ((f32x4){bflo(u.x), bfhi(u.x), bflo(u.y), bfhi(u.y)} * rstd) * gg[2 * j];
                    orow[128 * j + 1] = ((f32x4){bflo(u.z), bfhi(u.z), bflo(u.w), bfhi(u.w)} * rstd) * gg[2 * j + 1]; } }
        }
    }
}
__device__ __forceinline__ void rms_final_rows(int gw, int NGW, int lane, const float* X, float* out, const float* g) {
    f32x4 gg[16];
#pragma unroll
    for (int j = 0; j < 16; ++j) gg[j] = *(const GAS f32x4*)(g + 4 * lane + 256 * j);
    for (int m = gw; m < M; m += 2 * NGW) {
        const int m2 = m + NGW; const bool two = m2 < M;
        const GAS f32x4* xr = (const GAS f32x4*)(X + (size_t)m * DM) + lane; const GAS f32x4* xr2 = (const GAS f32x4*)(X + (size_t)(two ? m2 : m) * DM) + lane;
        f32x4 v[16], w[16];
#pragma unroll
        for (int j = 0; j < 16; ++j) v[j] = xr[64 * j];
#pragma unroll
        for (int j = 0; j < 16; ++j) w[j] = xr2[64 * j];
        ROWS_SBAR();
        float s = 0.f, s2 = 0.f;
#pragma unroll
        for (int j = 0; j < 16; ++j) s += (v[j].x * v[j].x + v[j].y * v[j].y) + (v[j].z * v[j].z + v[j].w * v[j].w);
        const float rstd = 1.0f / sqrtf(wave_sum(s) * (1.f / DM) + NORM_EPS);
        GAS f32x4* orow = (GAS f32x4*)(out + (size_t)m * DM) + lane;
#pragma unroll
        for (int j = 0; j < 16; ++j) orow[64 * j] = (v[j] * rstd) * gg[j];
#pragma unroll
        for (int j = 0; j < 16; ++j) s2 += (w[j].x * w[j].x + w[j].y * w[j].y) + (w[j].z * w[j].z + w[j].w * w[j].w);
        const float rstd2 = 1.0f / sqrtf(wave_sum(s2) * (1.f / DM) + NORM_EPS);
        if (two) { GAS f32x4* orow2 = (GAS f32x4*)(out + (size_t)m2 * DM) + lane;
#pragma unroll
            for (int j = 0; j < 16; ++j) orow2[64 * j] = (w[j] * rstd2) * gg[j]; }
    }
}
constexpr float HY_MIND = -3.0701134573253946f, HY_MAXD = -15.350567286626973f, HY_DSTEP = (HY_MAXD - HY_MIND) / (float)(HYW - 1);
typedef float f32x16 __attribute__((ext_vector_type(16)));
__device__ __forceinline__ void p1_kern(int gw, int NGW, int lane, const float* h3, const float* w4, float* kern) {
    const int l32 = lane & 31, hi = lane >> 5;
    for (int it = gw; it < (SEQ / 32) * 8; it += NGW) {
        const int tb = it >> 3, cg = it & 7, t = tb * 32 + l32;
        float hb[32];
#pragma unroll
        for (int q = 0; q < 8; ++q) { const f32x4 v = *(const GAS f32x4*)(h3 + (size_t)t * 64 + 32 * hi + 4 * q); hb[4 * q] = v.x; hb[4 * q + 1] = v.y; hb[4 * q + 2] = v.z; hb[4 * q + 3] = v.w; }
        const float tn = (float)t * (1.0f / (float)(SEQ - 1));
#pragma unroll 1
        for (int cb = 0; cb < 16; ++cb) {
            const int c0 = cg * 512 + cb * 32;
            float wa[32];
            { const GAS float* wp = (const GAS float*)w4 + (size_t)(32 * hi) * (2 * HYW) + c0 + l32;
#pragma unroll
              for (int sI = 0; sI < 32; ++sI) { wa[sI] = *wp; wp += 2 * HYW; asm volatile("" : "+v"(wp)); } }
            f32x16 d = {};
#pragma unroll
            for (int sI = 0; sI < 32; ++sI) d = __builtin_amdgcn_mfma_f32_32x32x2f32(wa[sI], hb[sI], d, 0, 0, 0);
            const bool fwd = c0 < HYW; const int cbase = (c0 & (HYW - 1)) + 4 * hi;
            const int idx = fwd ? t : ((t == 0) ? SEQ : FFTN - t);
            GAS float* kp = (GAS float*)kern + (size_t)cbase * FFTN + idx;
#pragma unroll
            for (int r = 0; r < 16; ++r) { const int c = cbase + (r & 3) + 8 * (r >> 2);
                const float delta = fabsf(HY_MIND + (float)c * HY_DSTEP); float val = d[r] * expf(-tn * delta);
                if (!fwd && t == 0) val = 0.f;
                *kp = val; kp += ((r & 3) == 3 ? 5 : 1) * FFTN; asm volatile("" : "+v"(kp)); }
        }
    }
}
__device__ __forceinline__ void p3_rope(int gw, int NGW, int lane, bf16* proj, const f32x2* rope) {
    const int mp = lane >> 3, dc = lane & 7;
    for (int m = gw; m < M; m += NGW) {
        f32x4 cs[4];
#pragma unroll
        for (int i = 0; i < 4; ++i) cs[i] = *(const GAS f32x4*)((const float*)(rope + (size_t)m * 64 + 8 * dc) + 4 * i);
#pragma unroll
        for (int it = 0; it < 4; ++it) {
            bf16* p = proj + (size_t)m * NIN + QOFF + (it * 8 + mp) * 128 + 8 * dc;
            const v4u a = *(const GAS v4u*)p, b = *(const GAS v4u*)(p + 64); v4u oa, ob;
#pragma unroll
            for (int w = 0; w < 4; ++w) {
                const float x1l = bflo(a[w]), x1h = bfhi(a[w]), x2l = bflo(b[w]), x2h = bfhi(b[w]);
                const float cl = cs[w].x, sl = cs[w].y, ch = cs[w].z, sh = cs[w].w;
                oa[w] = pk2(x1l * cl - x2l * sl, x1h * ch - x2h * sh); ob[w] = pk2(x2l * cl + x1l * sl, x2h * ch + x1h * sh); }
            *(GAS v4u*)p = oa; *(GAS v4u*)(p + 64) = ob;
        }
    }
}
__device__ __forceinline__ void p3_hyena_pre(int vcu, int G, int tid, LAS unsigned char* lds, const bf16* proj, const float* conv_w, const float* conv_b, float* vxT, bf16* x0T) {
    constexpr int CT = 128, PIT = CT + 2;
    LAS unsigned short* s = (LAS unsigned short*)lds;
    const int wave = tid >> 6, lane = tid & 63;
    constexpr int NIT = (M / 64) * (HYW / CT), NCH = 3 * 66 * (CT / 8), NLD = (NCH + NTHR - 1) / NTHR;
    v4u R[NLD];
#define HP_LOAD(item) do { const int mt_ = (item) / (HYW / CT), ct_ = (item) % (HYW / CT), m0_ = mt_ * 64, b_ = m0_ / SEQ, t0_ = m0_ % SEQ, c0_ = ct_ * CT; \
        _Pragma("unroll") for (int i_ = 0; i_ < NLD; ++i_) { const int ch_ = tid + NTHR * i_; R[i_] = (v4u){0u, 0u, 0u, 0u}; \
            if (ch_ < NCH) { const int g_ = ch_ / (66 * (CT / 8)), rem_ = ch_ % (66 * (CT / 8)), tt_ = rem_ / (CT / 8), k8_ = rem_ % (CT / 8), t_ = t0_ + tt_ - 1; \
                if (t_ >= 0 && t_ < SEQ) R[i_] = *(const GAS v4u*)(proj + (size_t)(b_ * SEQ + t_) * NIN + g_ * HYW + c0_ + 8 * k8_); } } } while (0)
    int it = vcu;
    if (it < NIT) HP_LOAD(it);
    for (; it < NIT; it += G) {
        const int mt = it / (HYW / CT), ct = it % (HYW / CT), m0 = mt * 64, b = m0 / SEQ, t0 = m0 % SEQ, c0 = ct * CT;
        __syncthreads();
#pragma unroll
        for (int i = 0; i < NLD; ++i) { const int ch = tid + NTHR * i;
            if (ch < NCH) { const int g = ch / (66 * (CT / 8)), rem = ch % (66 * (CT / 8)), tt = rem / (CT / 8), k8 = rem % (CT / 8);
                LAS unsigned* d = (LAS unsigned*)(s + (g * 66 + tt) * PIT + 8 * k8); d[0] = R[i].x; d[1] = R[i].y; d[2] = R[i].z; d[3] = R[i].w; } }
        __syncthreads();
        if (it + G < NIT) HP_LOAD(it + G);
#pragma unroll 4
        for (int q = 0; q < CT / 8; ++q) {
            const int cc = wave * (CT / 8) + q, c = c0 + cc; float r[3];
#pragma unroll
            for (int g = 0; g < 3; ++g) { const int ch = g * HYW + c; const float w0 = conv_w[ch], w1 = conv_w[3 * HYW + ch], w2 = conv_w[6 * HYW + ch], bb = conv_b[ch];
                const LAS unsigned short* sp = s + (g * 66 + lane) * PIT + cc;
                r[g] = ((bb + bf2f(sp[0]) * w0) + bf2f(sp[PIT]) * w1) + bf2f(sp[2 * PIT]) * w2; }
            const size_t o = ((size_t)c * 2 + b) * SEQ + t0 + lane;
            vxT[o] = r[2] * r[1]; x0T[o] = (bf16)f2bf(r[0]);
        }
    }
#undef HP_LOAD
}
constexpr float kC32[16] = {1.0f, 0.98078528040323043f, 0.92387953251128674f, 0.83146961230254524f, 0.70710678118654752f, 0.55557023301960218f, 0.38268343236508977f, 0.19509032201612825f,
                            0.0f, -0.19509032201612825f, -0.38268343236508977f, -0.55557023301960218f, -0.70710678118654752f, -0.83146961230254524f, -0.92387953251128674f, -0.98078528040323043f};
constexpr float kS32[16] = {0.0f, 0.19509032201612825f, 0.38268343236508977f, 0.55557023301960218f, 0.70710678118654752f, 0.83146961230254524f, 0.92387953251128674f, 0.98078528040323043f,
                            1.0f, 0.98078528040323043f, 0.92387953251128674f, 0.83146961230254524f, 0.70710678118654752f, 0.55557023301960218f, 0.38268343236508977f, 0.19509032201612825f};
__host__ __device__ constexpr int brev(int r, int bits) { int o = 0; for (int i = 0; i < bits; ++i) o = (o << 1) | ((r >> i) & 1); return o; }
template <int A, int N, int LO, int SG, int I> struct Bf {
    static __device__ __forceinline__ void run(f32x2 (&x)[A]) {
        if constexpr (I < N / 2) {
            constexpr int H = N / 2, ti = I * (32 / N);
            constexpr float c = kC32[ti], s = (float)SG * kS32[ti];
            const f32x2 a = x[LO + I], b = x[LO + I + H], d = a - b;
            x[LO + I] = a + b;
            if constexpr (ti == 0) x[LO + I + H] = d;
            else if constexpr (ti == 8) x[LO + I + H] = (f32x2){-s * d.y, s * d.x};
            else x[LO + I + H] = (f32x2){d.x * c - d.y * s, d.x * s + d.y * c};
            Bf<A, N, LO, SG, I + 1>::run(x);
        }
    }
};
template <int A, int N, int LO, int SG> __device__ __forceinline__ void dif(f32x2 (&x)[A]) {
    if constexpr (N >= 2) { Bf<A, N, LO, SG, 0>::run(x); dif<A, N / 2, LO, SG>(x); dif<A, N / 2, LO + N / 2, SG>(x); }
}
__device__ __forceinline__ f32x2 twid(int p) { const float a = (float)p * (1.0f / (float)FFTN); return (f32x2){__builtin_amdgcn_cosf(a), -__builtin_amdgcn_sinf(a)}; }
__device__ __forceinline__ void fft_p1_fwd_one(int j, f32x2 (&x)[16], LAS f32x2* L) {
    dif<16, 16, 0, -1>(x);
    LAS f32x2* p = L + j + (j >> 5);
    int jo = j; asm volatile("" : "+v"(jo));
    { const f32x2 w1 = twid(jo); f32x2 w = w1;
      p[0] = x[0];
#pragma unroll
      for (int m = 1; m < 16; ++m) { p[1056 * m] = cmul(x[brev(m, 4)], w); if (m < 15) w = cmul(w, w1); } }
}
template <int SG> __device__ __forceinline__ void fft_p2(int tid, LAS f32x2* L, const GAS f32x2* T) {
    const int B = tid >> 5, j = tid & 31; LAS f32x2* p = L + B * 1056 + j;
    int jo = 16 * j; asm volatile("" : "+v"(jo));
    f32x2 x[32];
#pragma unroll
    for (int k = 0; k < 32; ++k) { f32x2 v = p[33 * k]; if (SG > 0 && k != 0) v = cmulc(v, twid(jo * k)); x[k] = v; }
    dif<32, 32, 0, SG>(x);
#pragma unroll
    for (int r = 0; r < 32; ++r) { const int m = brev(r, 5); f32x2 v = x[r]; if (SG < 0 && m != 0) v = cmul(v, twid(jo * m)); p[33 * m] = v; }
}
#define FFT_WSYNC() do { asm volatile("s_waitcnt lgkmcnt(0)" ::: "memory"); } while (0)
__device__ __forceinline__ void p4_fft(int vcu, int G, int tid, LAS unsigned char* lds, const float* kern, const float* vxT, const bf16* x0T, const float* hbias, bf16* yT, f32x2* kspec) {
    LAS f32x2* L = (LAS f32x2*)lds;
    LAS f32x2* p3 = L + 33 * tid;
    GAS f32x2* ks = (GAS f32x2*)kspec + tid;
    float ka[16], kb[16];
    int c = vcu;
    if (c < HYW) { const GAS float* kp = (const GAS float*)(kern + (size_t)c * FFTN) + tid;
#pragma unroll
        for (int k = 0; k < 16; ++k) { ka[k] = kp[0]; kb[k] = kp[512]; kp += 1024; asm volatile("" : "+v"(kp)); } }
    for (; c < HYW; c += G) {
        const float* v0 = vxT + (size_t)c * 2 * SEQ; const float* v1 = v0 + SEQ;
        f32x2 da[16], db[16];
        { const GAS float* vp = (const GAS float*)v0 + tid;
#pragma unroll
          for (int k = 0; k < 8; ++k) { da[k] = (f32x2){vp[0], vp[SEQ]}; db[k] = (f32x2){vp[512], vp[SEQ + 512]}; vp += 1024; asm volatile("" : "+v"(vp)); } }
#pragma unroll
        for (int k = 8; k < 16; ++k) { da[k] = (f32x2){0.f, 0.f}; db[k] = (f32x2){0.f, 0.f}; }
        { f32x2 x[16];
#pragma unroll
          for (int k = 0; k < 16; ++k) x[k] = (f32x2){ka[k], 0.f};
          fft_p1_fwd_one(tid, x, L);
#pragma unroll
          for (int k = 0; k < 16; ++k) x[k] = (f32x2){kb[k], 0.f};
          fft_p1_fwd_one(tid + 512, x, L); }
        __syncthreads();
        fft_p2<-1>(tid, L, nullptr);
        FFT_WSYNC();
        {
            f32x2 Kr[32];
#pragma unroll
            for (int i = 0; i < 32; ++i) Kr[i] = p3[i];
            dif<32, 32, 0, -1>(Kr);
            GAS f32x2* kp = ks;
#pragma unroll
            for (int i = 0; i < 32; ++i) { *kp = Kr[i] * (1.0f / (float)FFTN); kp += 512; asm volatile("" : "+v"(kp)); }
        }
        __syncthreads();
        fft_p1_fwd_one(tid, da, L); fft_p1_fwd_one(tid + 512, db, L);
        __syncthreads();
        fft_p2<-1>(tid, L, nullptr);
        FFT_WSYNC();
        {
            f32x2 x[32], y[32];
#pragma unroll
            for (int i = 0; i < 32; ++i) x[i] = p3[i];
            dif<32, 32, 0, -1>(x);
            const GAS f32x2* kp = ks;
#pragma unroll
            for (int r = 0; r < 32; ++r) { x[r] = cmul(x[r], *kp); kp += 512; asm volatile("" : "+v"(kp)); }
#pragma unroll
            for (int m = 0; m < 32; ++m) y[m] = x[brev(m, 5)];
            dif<32, 32, 0, 1>(y);
#pragma unroll
            for (int r = 0; r < 32; ++r) p3[brev(r, 5)] = y[r];
        }
        FFT_WSYNC();
        if (c + G < HYW) { const GAS float* kp = (const GAS float*)(kern + (size_t)(c + G) * FFTN) + tid;
#pragma unroll
            for (int k = 0; k < 16; ++k) { ka[k] = kp[0]; kb[k] = kp[512]; kp += 1024; asm volatile("" : "+v"(kp)); } }
        fft_p2<1>(tid, L, nullptr);
        __syncthreads();
        const float hb = hbias[c];
        const bf16* x0p = x0T + (size_t)c * 2 * SEQ; bf16* yp = yT + (size_t)c * 2 * SEQ;
#pragma unroll 1
        for (int jj = 0; jj < 2; ++jj) { const int j = tid + 512 * jj;
            f32x2 x[16]; LAS f32x2* p = L + j + (j >> 5);
            int jo = j; asm volatile("" : "+v"(jo));
            { const f32x2 w1 = twid(jo); f32x2 w = w1;
#pragma unroll
              for (int m = 0; m < 16; ++m) { f32x2 v = p[1056 * m]; if (m != 0) { v = cmulc(v, w); if (m < 15) w = cmul(w, w1); } x[m] = v; } }
            dif<16, 16, 0, 1>(x);
#pragma unroll
            for (int r = 0; r < 16; ++r) { const int k = brev(r, 4);
                if (k < 8) { const int t = j + 1024 * k;
                    const float y0 = (x[r].x + v0[t] * hb) * bf2f(x0p[t]), y1 = (x[r].y + v1[t] * hb) * bf2f(x0p[SEQ + t]);
                    yp[t] = (bf16)f2bf(y0); yp[SEQ + t] = (bf16)f2bf(y1); } }
        }
        __syncthreads();
    }
}
__device__ __forceinline__ void attn_unit(int P, char* lds, const bf16* proj, float* O0, bf16* ymix, const float* lamp, const float* subg) {
    const int qb = P & 31, h = (P >> 5) & 7, b = P >> 8;
    const att9::bf16* Pj = (const att9::bf16*)proj;
    const size_t row0 = (size_t)(b * SEQ + qb * 256);
    const att9::bf16* Vh = Pj + (size_t)(b * SEQ) * NIN + VOFF + h * 256;
    float* Ob = O0 + ((size_t)((P / (int)gridDim.x) & 1) * gridDim.x + blockIdx.x) * (NTHR * 128);
    unsigned short* Yb = ymix + row0 * DM + HYW + h * 256;
#pragma unroll 1
    for (int j = 0; j < 2; ++j) {
        const float lam = *lamp;
        int seq = SEQ; asm volatile("" : "+s"(seq));
        att16::attn_body(j, Pj + row0 * NIN + QOFF + h * 256 + j * 128, Pj + (size_t)(b * SEQ) * NIN + KOFF + h * 256 + j * 128, Vh, Ob, Yb, lam, subg, seq, lds);
        __syncthreads();
    }
}
__device__ __forceinline__ void p5_hyena_post(int vcu, int G, int tid, LAS unsigned char* lds, const bf16* yT, bf16* ymix) {
    LAS unsigned short* s = (LAS unsigned short*)lds;
    constexpr int NIT = (M / 64) * (HYW / 64);
    const int c = tid >> 3, k8 = tid & 7;
#define POST_LOAD(item) (*(const GAS v4u*)(yT + ((size_t)(((item) & 31) * 64 + c) * 2 + (((item) >> 5) * 64) / SEQ) * SEQ + (((item) >> 5) * 64) % SEQ + 8 * k8))
    int it = vcu; v4u v = {0u, 0u, 0u, 0u};
    if (it < NIT) v = POST_LOAD(it);
    for (; it < NIT; it += G) {
        const int mt = it >> 5, ct = it & 31, m0 = mt * 64, c0 = ct * 64;
        __syncthreads();
        { LAS unsigned* d = (LAS unsigned*)(s + c * 66 + 8 * k8); d[0] = v.x; d[1] = v.y; d[2] = v.z; d[3] = v.w; }
        __syncthreads();
        if (it + G < NIT) v = POST_LOAD(it + G);
        { const int t = tid >> 3; const LAS unsigned short* sp = s + (8 * k8) * 66 + t; v4u o;
          o.x = (unsigned)sp[0 * 66] | ((unsigned)sp[1 * 66] << 16); o.y = (unsigned)sp[2 * 66] | ((unsigned)sp[3 * 66] << 16);
          o.z = (unsigned)sp[4 * 66] | ((unsigned)sp[5 * 66] << 16); o.w = (unsigned)sp[6 * 66] | ((unsigned)sp[7 * 66] << 16);
          *(GAS v4u*)(ymix + (size_t)(m0 + t) * DM + c0 + 8 * k8) = o; }
    }
#undef POST_LOAD
}
struct Args { const void* in[29]; float* out; unsigned char* ws; int ph_lo, ph_hi; };
static_assert(sizeof(Args) == 256, "Args has no padding bytes");
enum { I_X = 0, I_C, I_POS, I_WADA, I_BADA, I_GMIX, I_GFFN, I_WIN, I_CONVW, I_CONVB, I_FW1, I_FB1, I_FW2, I_FB2, I_FW3, I_FB3, I_FW4, I_FFREQ, I_HBIAS,
       I_LQ1, I_LK1, I_LQ2, I_LK2, I_SUBG, I_WOUT, I_WGATE, I_WUP, I_WDOWN, I_GFINAL };
__global__ void __launch_bounds__(NTHR, 2) mega_fwd(Args args) {
    extern __shared__ __attribute__((aligned(16))) unsigned char lds[];
    LAS unsigned char* const L = (LAS unsigned char*)lds;
    volatile LAS unsigned* const MISC = (volatile LAS unsigned*)(L + MISC_OFF);
    const int tid = threadIdx.x, lane = tid & 63, wave = __builtin_amdgcn_readfirstlane(tid >> 6);
    const int G = gridDim.x, bx = blockIdx.x, NGW = G * NWAVES, NGT = G * NTHR;
    int vcu = (G % 8 == 0) ? (bx % 8) * (G / 8) + bx / 8 : bx, cid = bx;
    int gw = vcu * NWAVES + wave, gt = vcu * NTHR + tid;
    unsigned char* const ws = args.ws;
    gu32* const ctl = (gu32*)(ws + WS_CTL);
#define INF(k) ((const float*)args.in[k])
    float* const mod = (float*)(ws + WS_CTL) + CW_MOD;
    f32x2* const tw = (f32x2*)(ws + WS_TW); float* const h3 = (float*)(ws + WS_H3); f32x2* const rope = (f32x2*)(ws + WS_ROPE);
    bf16* const WIN = (bf16*)(ws + WS_WIN); bf16* const WOUT = (bf16*)(ws + WS_WOUT); bf16* const WGU = (bf16*)(ws + WS_WGU); bf16* const WDN = (bf16*)(ws + WS_WDN);
    bf16* const HA = (bf16*)(ws + WS_HA); bf16* const X0T = (bf16*)(ws + WS_X0T); bf16* const YT = (bf16*)(ws + WS_YT);
    bf16* const PROJ = (bf16*)(ws + WS_PROJ); bf16* const ACT = (bf16*)(ws + WS_ACT); bf16* const YMIX = (bf16*)(ws + WS_YMIX);
    bf16* const X1 = (bf16*)(ws + WS_X1); float* const O0 = (float*)(ws + WS_O0);
    float* const KERN = (float*)(ws + WS_KERN); float* const VXT = (float*)(ws + WS_VXT); bf16* const X2 = (bf16*)(ws + WS_X2);

    for (int u = tid; u < (LDS_BYTES - LDSCTL_OFF) / 4; u += NTHR) ((LAS unsigned*)(L + LDSCTL_OFF))[u] = 0u;
    __syncthreads();
    XcdBarrier bar; bar.bar = (unsigned*)(ctl + CW_BAR); bar.x = 0; bar.st = nullptr;
    if (N_LAUNCHES != PER_PHASE) bar = xcd_barrier_post((unsigned*)(ctl + CW_BAR), MISC + 8);
    const unsigned my_xcc = (unsigned)__builtin_amdgcn_readfirstlane((int)(xb_xcc_id() & 7u));
    if (N_LAUNCHES != PER_PHASE && tid == 0) MISC[16] = __hip_atomic_fetch_add((unsigned*)(ctl + CW_XRANK + 64 * my_xcc), 1u, RLX_AGENT);
#define GRID_BAR(seam) do { if (N_LAUNCHES == PER_PHASE) { if (tid == 0) __hip_atomic_store(ctl + CW_TMO, 0xBADBA0u | (unsigned)(seam), RLX_AGENT); } else { xcd_barrier(bar); } } while (0)
    const int lo = args.ph_lo, hi = args.ph_hi;
#define IN(k) (lo <= (k) && (k) < hi)
#define BOTH(k) (IN(k) && IN((k) + 1))

    if (IN(0)) {
        p0_adaln(gw, NGW, lane, INF(I_C), INF(I_WADA), INF(I_BADA), mod);
        p0_filter_mlp(gw, NGW, lane, INF(I_FW1), INF(I_FB1), INF(I_FW2), INF(I_FB2), INF(I_FW3), INF(I_FB3), INF(I_FFREQ), h3);
        p0_tables(gt, NGT, (const int*)args.in[I_POS], rope, tw);
        if (bx == 0 && wave == 0) {
            const float* lq1 = INF(I_LQ1); const float* lk1 = INF(I_LK1); const float* lq2 = INF(I_LQ2); const float* lk2 = INF(I_LK2);
            const float s1 = wave_sum(lq1[lane] * lk1[lane] + lq1[lane + 64] * lk1[lane + 64]), s2 = wave_sum(lq2[lane] * lk2[lane] + lq2[lane + 64] * lk2[lane + 64]);
            if (lane == 0) *(float*)(ctl + CW_LAM) = expf(s1) - expf(s2) + LAM_INIT; }
        p0_weights(gw, NGW, wave, lane, L, INF(I_WIN), INF(I_WOUT), INF(I_WGATE), INF(I_WUP), INF(I_WDOWN), WIN, WOUT, WGU, WDN);
        if (BOTH(0)) GRID_BAR(0);
    }
    if (N_LAUNCHES != PER_PHASE && (G % 8) == 0) {
        bool even = true;
#pragma unroll
        for (int j = 0; j < 8; ++j) even = even && (__hip_atomic_load((unsigned*)(ctl + CW_XRANK + 64 * j), RLX_AGENT) == (unsigned)(G / 8));
        const int rank = __builtin_amdgcn_readfirstlane((int)MISC[16]);
        if (even) { vcu = (int)my_xcc * (G / 8) + rank; cid = rank * 8 + (int)my_xcc; gw = vcu * NWAVES + wave; gt = vcu * NTHR + tid; }
    }
    if (IN(1)) {
        rms_mod_table(tid, L, INF(I_GMIX), mod, 0 * DM, 1 * DM); __syncthreads();
        if (wave < NWAVES / 2) { p1_kern(gw, NGW, lane, h3, INF(I_FW4), KERN); rms_mod_rows(gw, NGW, lane, L, INF(I_X), HA); }
        else { rms_mod_rows(gw, NGW, lane, L, INF(I_X), HA); p1_kern(gw, NGW, lane, h3, INF(I_FW4), KERN); }
        __syncthreads();
        if (BOTH(1)) GRID_BAR(1);
    }
    if (IN(2)) {
        pg8::Gemm g{HA, WIN, M, NIN, DM}; pg8::StaticOrder S; S.init(M, NIN, G, cid);
        pg8::EpiBf16Rope E{PROJ, NIN, (const float*)rope, QOFF / 256, VOFF / 256};
        pg8::gemm_phase<pg8::EpiBf16Rope, pg8::StaticOrder, true, true>(L, g, S, E);
        if (BOTH(2)) GRID_BAR(2);
    }
    if (IN(3)) {
        p3_hyena_pre(vcu, G, tid, L, PROJ, INF(I_CONVW), INF(I_CONVB), VXT, X0T);
        if (BOTH(3)) GRID_BAR(3);
    }
    if (IN(4)) {
        __syncthreads();
        p4_fft(vcu, G, tid, L, KERN, VXT, X0T, INF(I_HBIAS), YT, (f32x2*)(ws + WS_KSPEC) + (size_t)bx * FFTN);
        for (int U = vcu; U < 512; U += G) attn_unit(U, (char*)lds, PROJ, O0, YMIX, (const float*)(ctl + CW_LAM), INF(I_SUBG));
        if (BOTH(4)) GRID_BAR(4);
    }
    if (IN(5)) {
        p5_hyena_post(vcu, G, tid, L, YT, YMIX);
        if (BOTH(5)) GRID_BAR(5);
    }
    if (IN(6)) {
        __syncthreads();
        pg8::Gemm g{YMIX, WOUT, M, DM, DM}; pg8::StaticOrder S; S.init(M, DM, G, cid);
        pg8::EpiGateResB16<false> E{INF(I_X), X1, DM, mod + 2 * DM, NMOD, SEQ / 256};
        pg8::gemm_phase<pg8::EpiGateResB16<false>, pg8::StaticOrder, true, true>(L, g, S, E);
        if (BOTH(6)) GRID_BAR(6);
    }
    if (IN(7)) {
        rms_mod_table(tid, L, INF(I_GFFN), mod, 3 * DM, 4 * DM); __syncthreads();
        rms_mod_rows_b16(gw, NGW, lane, L, X1, HA);
        __syncthreads();
        if (BOTH(7)) GRID_BAR(7);
    }
    if (IN(8)) {
        pg8::Gemm g{HA, WGU, M, NGU, DM}; pg8::StaticOrder S; S.init(M, NGU, G, cid);
        pg8::EpiSwiGlu E{ACT, FFN};
        pg8::gemm_phase<pg8::EpiSwiGlu, pg8::StaticOrder, true, true>(L, g, S, E);
        if (BOTH(8)) GRID_BAR(8);
    }
    if (IN(9)) {
        pg8::Gemm g{ACT, WDN, M, DM, FFN}; pg8::StaticOrder S; S.init(M, DM, G, cid);
        pg8::EpiGateResB16<true> E{X1, X2, DM, mod + 5 * DM, NMOD, SEQ / 256};
        pg8::gemm_phase<pg8::EpiGateResB16<true>, pg8::StaticOrder, true, true>(L, g, S, E);
        if (BOTH(9)) GRID_BAR(9);
    }
    if (IN(10)) {
        rms_final_rows_b16(gw, NGW, lane, X2, args.out, INF(I_GFINAL));
    }
#undef IN
#undef BOTH
#undef INF
}
}

extern "C" void kernel_launch(void* const* d_in, const int* in_sizes, int n_in, void* d_out, int out_size, void* d_ws, size_t ws_size, hipStream_t stream) {
    using namespace mk;
    static int grid = 0;
    if (grid == 0) {
        if (n_in != 29 || in_sizes[0] != M * DM || out_size != M * DM || ws_size < WS_END) {
            fprintf(stderr, "kernel_launch: built for 29 inputs, x/out of %d floats, >= %zu bytes of workspace; got n_in %d, in0 %d, out %d, ws %zu; nothing launched\n", M * DM, (size_t)WS_END, n_in, n_in > 0 ? in_sizes[0] : -1, out_size, ws_size);
            grid = -1; return; }
        int dev = 0, cus = 0, per_cu = 0;
        if (hipGetDevice(&dev) != hipSuccess || hipDeviceGetAttribute(&cus, hipDeviceAttributeMultiprocessorCount, dev) != hipSuccess) { fprintf(stderr, "kernel_launch: device query failed\n"); grid = -1; return; }
        if (hipFuncSetAttribute((const void*)mega_fwd, hipFuncAttributeMaxDynamicSharedMemorySize, LDS_BYTES) != hipSuccess) { fprintf(stderr, "kernel_launch: hipFuncSetAttribute(%d B LDS) failed\n", LDS_BYTES); grid = -1; return; }
        if (hipOccupancyMaxActiveBlocksPerMultiprocessor(&per_cu, (const void*)mega_fwd, NTHR, LDS_BYTES) != hipSuccess || per_cu < 1) {
            fprintf(stderr, "kernel_launch: occupancy query reports %d workgroups per CU; nothing launched\n", per_cu); (void)hipGetLastError(); grid = -1; return; }
        grid = cus > 256 ? 256 : cus;
    }
    if (grid < 0) return;
    if (hipMemsetAsync((char*)d_ws + WS_CTL, 0, CTL_ZERO_BYTES, stream) != hipSuccess) { fprintf(stderr, "kernel_launch: hipMemsetAsync failed\n"); return; }
    Args a{};
    for (int i = 0; i < 29; ++i) a.in[i] = d_in[i];
    a.out = (float*)d_out; a.ws = (unsigned char*)d_ws;
    if (N_LAUNCHES == 1) {
        a.ph_lo = 0; a.ph_hi = PER_PHASE;
        hipLaunchKernelGGL(mega_fwd, dim3(grid), dim3(NTHR), LDS_BYTES, stream, a);
    } else {
        for (int p = 0; p < PER_PHASE; ++p) { a.ph_lo = p; a.ph_hi = p + 1; hipLaunchKernelGGL(mega_fwd, dim3(grid), dim3(NTHR), LDS_BYTES, stream, a); }
    }
    const hipError_t le = hipPeekAtLastError();
    if (le != hipSuccess) fprintf(stderr, "kernel_launch: launch failed: %s (grid %d x %d threads, %d B LDS)\n", hipGetErrorName(le), grid, NTHR, LDS_BYTES);
}
```
